# Optimizing an MI355X kernel written in HIP

```python
import jax, jax.numpy as jnp
from jax import lax
import numpy as np

D_MODEL = 1024
BATCH = 4
SEQ = 4096
DEPTH = 2

N_MIXERS = 2

A_HEADS = 8
A_HEAD_DIM = 128
A_WIDTH = A_HEADS * A_HEAD_DIM
A_KV_LATENT = 256
IDX_HEADS = 8
IDX_DIM = 64
TOPK_MAX = 256
Q_BLOCK = 128
A_IN_COLS = A_WIDTH + A_KV_LATENT + IDX_HEADS * IDX_DIM + IDX_DIM + IDX_HEADS + A_WIDTH

B_HEADS = 4
B_WIDTH = 2 * D_MODEL
B_V_DIM = B_WIDTH // B_HEADS
B_QK_DIM = B_V_DIM // 2
B_QK_COLS = 2 * B_HEADS * B_QK_DIM
CONV_WIDTH = 4
CHUNK = 64
B_IN_COLS = B_QK_COLS + B_WIDTH + 2 * B_HEADS + B_WIDTH + B_WIDTH

N_A_LAYERS = (DEPTH + 1) // 2
N_B_LAYERS = DEPTH // 2
DEEPNORM_ALPHA = (2 * DEPTH) ** 0.25
DEEPNORM_BETA = (8 * DEPTH) ** -0.25
NORM_EPS = 1e-5

kernel_name = "dsa_mlstm_interleaved_deepnorm"


def _split_points(sizes):
    return [int(s) for s in np.cumsum(sizes)]


def _layernorm(x, g, b):
    xf = x.astype(jnp.float32)
    mu = jnp.mean(xf, axis=-1, keepdims=True)
    var = jnp.mean(jnp.square(xf - mu), axis=-1, keepdims=True)
    return ((xf - mu) * lax.rsqrt(var + NORM_EPS) * g + b).astype(x.dtype)


def _rmsnorm(x, g):
    xf = x.astype(jnp.float32)
    return xf * lax.rsqrt(jnp.mean(xf * xf, axis=-1, keepdims=True) + NORM_EPS) * g


def _dsa_mixer(x, w_in, kv_norm_g, w_uk, w_uv, w_out):
    f32 = jnp.float32
    B, T, _ = x.shape
    topk = min(TOPK_MAX, T // 4)
    nb = T // Q_BLOCK
    proj = x @ w_in
    q, c_kv, q_idx, k_idx, w_idx, z = jnp.split(
        proj, _split_points([A_WIDTH, A_KV_LATENT, IDX_HEADS * IDX_DIM, IDX_DIM, IDX_HEADS]), axis=-1)
    q = q.reshape(B, T, A_HEADS, A_HEAD_DIM)
    c_kv = _rmsnorm(c_kv, kv_norm_g)
    q_lat = jnp.einsum('bthd,hdc->bthc', q, w_uk).astype(f32) * (A_HEAD_DIM ** -0.5)
    q_idx = q_idx.reshape(B, T, IDX_HEADS, IDX_DIM).astype(f32)
    k_idx = k_idx.astype(f32)
    w_idx = w_idx.astype(f32)
    slopes = 2.0 ** (-8.0 * jnp.arange(1, A_HEADS + 1, dtype=f32) / A_HEADS)
    s_pos = jnp.arange(T)

    def to_blocks(a):
        return a.reshape(B, nb, Q_BLOCK, *a.shape[2:]).swapaxes(0, 1)

    def block(args):
        blk, qb, qib, wb = args
        t_pos = blk * Q_BLOCK + jnp.arange(Q_BLOCK)
        rel = jax.nn.relu(jnp.einsum('bqhd,bsd->bqhs', qib, k_idx))
        idx_score = jnp.einsum('bqh,bqhs->bqs', wb, rel)
        causal = s_pos[None, :] <= t_pos[:, None]
        idx_score = jnp.where(causal[None], idx_score, -jnp.inf)
        _, sel = lax.top_k(idx_score, topk)
        c_sel = jax.vmap(lambda c, i: c[i])(c_kv, sel)
        logits = jnp.einsum('bqhc,bqkc->bqhk', qb, c_sel)
        dist = t_pos[None, :, None] - sel
        logits = logits - slopes[None, None, :, None] * dist[:, :, None, :].astype(f32)
        logits = jnp.where((dist >= 0)[:, :, None, :], logits, -jnp.inf)
        p = jax.nn.softmax(logits, axis=-1)
        return jnp.einsum('bqhk,bqkc->bqhc', p, c_sel)

    o_lat = lax.map(block, (jnp.arange(nb), to_blocks(q_lat), to_blocks(q_idx), to_blocks(w_idx)))
    o_lat = o_lat.swapaxes(0, 1).reshape(B, T, A_HEADS, A_KV_LATENT)
    o = jnp.einsum('bthc,hcd->bthd', o_lat, w_uv.astype(f32)).reshape(B, T, A_WIDTH).astype(x.dtype)
    return (o * jax.nn.silu(z)) @ w_out


def _causal_conv(u, w, b):
    T = u.shape[1]
    up = jnp.pad(u, ((0, 0), (CONV_WIDTH - 1, 0), (0, 0)))
    return sum(up[:, j:j + T] * w[j] for j in range(CONV_WIDTH)) + b


def _mlstm_mixer(x, w_in, i_bias, f_bias, conv_w, conv_b, head_norm_g, w_out):
    f32 = jnp.float32
    B, T, _ = x.shape
    nc = T // CHUNK
    proj = x @ w_in
    qk, v, ig, fg, o, z = jnp.split(
        proj, _split_points([B_QK_COLS, B_WIDTH, B_HEADS, B_HEADS, B_WIDTH]), axis=-1)
    qk = jax.nn.silu(_causal_conv(qk, conv_w, conv_b))
    q, k = jnp.split(qk, 2, axis=-1)

    def heads(a, d):
        return a.reshape(B, nc, CHUNK, B_HEADS, d).transpose(1, 0, 3, 2, 4).astype(f32)

    def gates(a):
        return a.astype(f32).reshape(B, nc, CHUNK, B_HEADS).transpose(1, 0, 3, 2)

    q = heads(q, B_QK_DIM) * (B_QK_DIM ** -0.5)
    k = heads(k, B_QK_DIM)
    v = heads(v, B_V_DIM)
    log_i = gates(ig + i_bias)
    log_f = jax.nn.log_sigmoid(gates(fg + f_bias))
    causal = jnp.tril(jnp.ones((CHUNK, CHUNK), dtype=bool))

    def step(carry, inp):
        C, n, m = carry
        qc, kc, vc, ic, fc = inp
        b = jnp.cumsum(fc, axis=-1)
        d_log = jnp.where(causal, b[..., :, None] - b[..., None, :] + ic[..., None, :], -jnp.inf)
        m_inter = b + m[..., None]
        m_t = jnp.maximum(m_inter, jnp.max(d_log, axis=-1))
        s = jnp.einsum('bhtd,bhsd->bhts', qc, kc) * jnp.exp(d_log - m_t[..., None])
        g_inter = jnp.exp(m_inter - m_t)
        num = jnp.einsum('bhts,bhsv->bhtv', s, vc) + g_inter[..., None] * jnp.einsum('bhtd,bhdv->bhtv', qc, C)
        den = jnp.sum(s, axis=-1) + g_inter * jnp.einsum('bhtd,bhd->bht', qc, n)
        h = num / jnp.maximum(jnp.abs(den), jnp.exp(-m_t))[..., None]
        b_end = b[..., -1]
        w_log = b_end[..., None] - b + ic
        m_new = jnp.maximum(b_end + m, jnp.max(w_log, axis=-1))
        decay = jnp.exp(b_end + m - m_new)
        w_s = jnp.exp(w_log - m_new[..., None])
        C_new = decay[..., None, None] * C + jnp.einsum('bhs,bhsd,bhsv->bhdv', w_s, kc, vc)
        n_new = decay[..., None] * n + jnp.einsum('bhs,bhsd->bhd', w_s, kc)
        return (C_new, n_new, m_new), h

    init = (jnp.zeros((B, B_HEADS, B_QK_DIM, B_V_DIM), f32),
            jnp.zeros((B, B_HEADS, B_QK_DIM), f32),
            jnp.zeros((B, B_HEADS), f32))
    _, h = lax.scan(step, init, (q, k, v, log_i, log_f))
    h = h.transpose(1, 0, 3, 2, 4).reshape(B, T, B_HEADS, B_V_DIM)
    h = _rmsnorm(h, head_norm_g)
    h = jax.nn.sigmoid(o.astype(f32)).reshape(B, T, B_HEADS, B_V_DIM) * h
    h = h.reshape(B, T, B_WIDTH).astype(x.dtype)
    return (h * jax.nn.silu(z)) @ w_out


def setup_inputs(seed: int = 0) -> dict:
    key = jax.random.key(seed)
    ks = jax.random.split(key, 20)
    f32 = jnp.float32

    def nrm(k, shape, scale):
        return jax.random.normal(k, shape, f32) * scale

    nA, nB = N_A_LAYERS, N_B_LAYERS
    return {
        "x": nrm(ks[0], (BATCH, SEQ, D_MODEL), 1.0),
        "a_w_in": nrm(ks[1], (nA, D_MODEL, A_IN_COLS), D_MODEL ** -0.5),
        "a_kv_norm_g": 1.0 + nrm(ks[2], (nA, A_KV_LATENT), 0.02),
        "a_w_uk": nrm(ks[3], (nA, A_HEADS, A_HEAD_DIM, A_KV_LATENT), A_KV_LATENT ** -0.5),
        "a_w_uv": nrm(ks[4], (nA, A_HEADS, A_KV_LATENT, A_HEAD_DIM), A_KV_LATENT ** -0.5),
        "a_w_out": nrm(ks[5], (nA, A_WIDTH, D_MODEL), A_WIDTH ** -0.5 * DEEPNORM_BETA),
        "a_ln_g": 1.0 + nrm(ks[6], (nA, D_MODEL), 0.02),
        "a_ln_b": nrm(ks[7], (nA, D_MODEL), 0.02),
        "b_w_in": nrm(ks[8], (nB, D_MODEL, B_IN_COLS), D_MODEL ** -0.5),
        "b_i_bias": nrm(ks[9], (nB, B_HEADS), 0.1),
        "b_f_bias": jnp.linspace(3.0, 6.0, B_HEADS, dtype=f32)[None, :] + nrm(ks[10], (nB, B_HEADS), 0.1),
        "b_conv_w": nrm(ks[11], (nB, CONV_WIDTH, B_QK_COLS), CONV_WIDTH ** -0.5),
        "b_conv_b": nrm(ks[12], (nB, B_QK_COLS), 0.02),
        "b_head_norm_g": 1.0 + nrm(ks[13], (nB, B_HEADS, B_V_DIM), 0.02),
        "b_w_out": nrm(ks[14], (nB, B_WIDTH, D_MODEL), B_WIDTH ** -0.5 * DEEPNORM_BETA),
        "b_ln_g": 1.0 + nrm(ks[15], (nB, D_MODEL), 0.02),
        "b_ln_b": nrm(ks[16], (nB, D_MODEL), 0.02),
    }


def reference(x, a_w_in, a_kv_norm_g, a_w_uk, a_w_uv, a_w_out, a_ln_g, a_ln_b,
              b_w_in, b_i_bias, b_f_bias, b_conv_w, b_conv_b, b_head_norm_g, b_w_out,
              b_ln_g, b_ln_b):
    for layer in range(DEPTH):
        j = layer // N_MIXERS
        if layer % N_MIXERS == 0:
            y = _dsa_mixer(x, a_w_in[j], a_kv_norm_g[j], a_w_uk[j], a_w_uv[j], a_w_out[j])
            x = _layernorm(DEEPNORM_ALPHA * x + y, a_ln_g[j], a_ln_b[j])
        else:
            y = _mlstm_mixer(x, b_w_in[j], b_i_bias[j], b_f_bias[j], b_conv_w[j], b_conv_b[j],
                             b_head_norm_g[j], b_w_out[j])
            x = _layernorm(DEEPNORM_ALPHA * x + y, b_ln_g[j], b_ln_b[j])
    return x
```

```cpp
#include <hip/hip_runtime.h>
#include <cstdio>
#include <cstdint>

#ifndef MK_ONE_LAUNCH
#define MK_ONE_LAUNCH 1
#endif

#define GAS __attribute__((address_space(1)))
#define LAS __attribute__((address_space(3)))
#define DI __device__ __forceinline__
typedef unsigned short bf16;
typedef short bf16x8 __attribute__((ext_vector_type(8)));
typedef short s16x4 __attribute__((ext_vector_type(4)));
typedef float f32x4 __attribute__((ext_vector_type(4)));
typedef float f32x2 __attribute__((ext_vector_type(2)));
typedef unsigned u32x4 __attribute__((ext_vector_type(4)));
typedef unsigned u32x2 __attribute__((ext_vector_type(2)));

constexpr int BATCH = 4, T = 4096, D = 1024, M = BATCH * T;
constexpr int A_IN = 2888, B_IN = 8200;
constexpr float LN_EPS = 1e-5f;
constexpr float ALPHA = 1.41421356237f;

constexpr size_t MiB = 1u << 20;
constexpr size_t WS_CTL = 0, CTL_ZERO_BYTES = 64 * 1024;
constexpr size_t WS_WA = 1 * MiB;
constexpr size_t WS_WUK = 7 * MiB;
constexpr size_t WS_WUVB = WS_WUK + MiB / 2;
constexpr size_t WS_WAO = WS_WUVB + MiB;
constexpr size_t WS_WBI = WS_WAO + 2 * MiB;
constexpr size_t WS_WBO = WS_WBI + 16 * MiB;
constexpr size_t WS_WG = WS_WBO + 4 * MiB;
constexpr size_t WS_GATES = WS_WG + 64 * 1024;
constexpr size_t WS_EXPM = WS_GATES + 512 * 1024;
constexpr size_t WS_DEC = WS_EXPM + 256 * 1024;
constexpr size_t WS_XB = 32 * MiB;
constexpr size_t WS_PA1 = 64 * MiB;
constexpr size_t WS_ZA = 128 * MiB;
constexpr size_t WS_CKV = 160 * MiB;
constexpr size_t WS_QLAT = 168 * MiB;
constexpr size_t WS_SEL = 232 * MiB;
constexpr size_t WS_V = 128 * MiB;
constexpr size_t WS_QG = 192 * MiB;
constexpr size_t WS_KT = 224 * MiB;
constexpr size_t WS_SS = 1 * MiB;
constexpr size_t WS_SSQ = WS_WBI;
constexpr size_t WS_END = 256 * MiB;
static_assert(WS_DEC + 4096 <= WS_XB, "ws map");

constexpr int CW_BAR = 1024;

constexpr int RING_BYTES = 131072;
constexpr int AUX_OFF = RING_BYTES;
constexpr int MISC_OFF = AUX_OFF + 8192;
constexpr int LDS_BYTES = 147456;

DI float bf2f(unsigned short u) { return __uint_as_float((unsigned)u << 16); }
DI float bflo(unsigned w) { return __uint_as_float(w << 16); }
DI float bfhi(unsigned w) { return __uint_as_float(w & 0xffff0000u); }
DI unsigned f2bf(float f) { unsigned u = __float_as_uint(f); return (u + 0x7fffu + ((u >> 16) & 1u)) >> 16; }
DI unsigned pk2(float lo, float hi) { return f2bf(lo) | (f2bf(hi) << 16); }
DI float wave_sum(float v) {
#pragma unroll
    for (int o = 1; o < 64; o <<= 1) v += __shfl_xor(v, o);
    return v;
}
DI int wave_sum_small(int c) {
    int tot = 0;
#pragma unroll
    for (int b = 0; b < 7; ++b) tot += __popcll(__ballot((c >> b) & 1)) << b;
    return tot;
}
DI float siluf(float x) { return x / (1.f + __expf(-x)); }
DI float sigmf(float x) { return 1.f / (1.f + __expf(-x)); }
#define LDS_WAIT() asm volatile("s_waitcnt lgkmcnt(0)" ::: "memory")
#define VM_WAIT() asm volatile("s_waitcnt vmcnt(0)" ::: "memory")

namespace pg8 {
typedef unsigned short bf16_t;
constexpr int BM = 256, BK = 64, HALF = 128, HTB = HALF * BK * 2, STAGE_BYTES = 8 * HTB, NXCD = 8, WGM = 8;
__host__ __device__ __forceinline__ int lds_byte(int r, int c) { const int st = (r >> 4) * 2 + (c >> 5), rr = r & 15, cc = c & 31, ob = rr * 64 + cc * 2; return st * 1024 + (ob ^ (((ob >> 9) & 1) << 5)); }
__host__ __device__ __forceinline__ void stage_rc(int b, int& R, int& C) { const int st = b / 1024, sb = b % 1024, swz = sb ^ (((sb >> 9) & 1) << 5); R = (st >> 1) * 16 + swz / 64; C = (st & 1) * 32 + (swz % 64) / 2; }
__host__ __device__ __forceinline__ int perm32(int rho) { const int n = rho >> 4, i = rho & 15; return 8 * (i >> 2) + 4 * n + (i & 3); }
struct Unit { int pm, pn; };
struct Gemm { const bf16_t* A; const bf16_t* Bt; int M, N, K, lda, ldb, a_pn_off; };
struct StaticOrder {
    int nM, nN, nwg, G, c;
    __host__ __device__ void init(int M_, int N_, int G_, int c_) { nM = M_ / BM; nN = N_ / BM; nwg = nM * nN; G = G_; c = c_; }
    __host__ __device__ bool next(int i, Unit& u) const {
        const long L = (long)i * G + c; if (L >= nwg) return false;
        int wgid = (int)L; { const int q = nwg / NXCD, r = nwg % NXCD, xcd = wgid % NXCD, off = wgid / NXCD; wgid = (xcd < r ? xcd * (q + 1) : r * (q + 1) + (xcd - r) * q) + off; }
        const int nig = WGM * nN, gid = wgid / nig, fm = gid * WGM, gsz = (nM - fm) < WGM ? (nM - fm) : WGM;
        u.pm = fm + ((wgid % nig) % gsz); u.pn = (wgid % nig) / gsz; return true;
    }
};
DI unsigned cvt_pk_bf16(float lo, float hi) { unsigned r; asm volatile("v_cvt_pk_bf16_f32 %0, %1, %2" : "=v"(r) : "v"(lo), "v"(hi)); return r; }

template <class Epi>
DI void gemm_phase(LAS unsigned char* lds, const Gemm g, const StaticOrder& S, const Epi& E) {
    const int tid = threadIdx.x, wid = __builtin_amdgcn_readfirstlane(tid >> 6), lane = tid & 63, wr = wid >> 2, wc = wid & 3, fr = lane & 15, fq = lane >> 4;
    const int nt = g.K / BK;
    unsigned voffA[2], voffB[2];
#pragma unroll
    for (int i = 0; i < 2; ++i) { int R, C; stage_rc(tid * 16 + i * 8192, R, C); const int Rb = Epi::PERM ? ((R & ~31) + perm32(R & 31)) : R;
        voffA[i] = (unsigned)(R * g.lda + C) * 2u; voffB[i] = (unsigned)(Rb * g.ldb + C) * 2u; }
    const size_t kstep = (size_t)(BK * 2);
    const size_t hA = (size_t)HALF * g.lda * 2, hB = (size_t)HALF * g.ldb * 2;
    const size_t tA = 2 * hA, tB = 2 * hB;
    const unsigned ldsw = (unsigned)wid * 1024u;
    const int aoff = lds_byte(wr * 64 + fr, fq * 8), boff = lds_byte(wc * 32 + fr, fq * 8);
#define PG8_SA(b, h) (((b) * 2 + (h)) * HTB)
#define PG8_SB(b, h) ((4 + (b) * 2 + (h)) * HTB)
#define PG8_STAGE(bufoff, gbase, voff) do { _Pragma("unroll") for (int _i = 0; _i < 2; ++_i) \
        __builtin_amdgcn_global_load_lds((const unsigned*)((const char*)(gbase) + (voff)[_i]), (LAS unsigned*)(lds + (bufoff) + ldsw + _i * 8192), 16, 0, 0); } while (0)
#define PG8_LDA(dst, b, h) do { _Pragma("unroll") for (int m = 0; m < 4; ++m) _Pragma("unroll") for (int k = 0; k < 2; ++k) dst[m][k] = *(const LAS bf16x8*)(lds + PG8_SA(b, h) + aoff + m * 2048 + k * 1024); } while (0)
#define PG8_LDB(dst, b, h) do { _Pragma("unroll") for (int n = 0; n < 2; ++n) _Pragma("unroll") for (int k = 0; k < 2; ++k) dst[n][k] = *(const LAS bf16x8*)(lds + PG8_SB(b, h) + boff + n * 2048 + k * 1024); } while (0)
#define PG8_MMA(ai, bj, At, Bt) do { __builtin_amdgcn_s_setprio(1); _Pragma("unroll") for (int m = 0; m < 4; ++m) _Pragma("unroll") for (int n = 0; n < 2; ++n) _Pragma("unroll") for (int k = 0; k < 2; ++k) \
        acc[ai][bj][m][n] = __builtin_amdgcn_mfma_f32_16x16x32_bf16(Bt[n][k], At[m][k], acc[ai][bj][m][n], 0, 0, 0); __builtin_amdgcn_s_setprio(0); } while (0)
#define PG8_WAIT_V(n) asm volatile("s_waitcnt vmcnt(" #n ")" ::: "memory")
#define PG8_WAIT_L(n) asm volatile("s_waitcnt lgkmcnt(" #n ")" ::: "memory")
#define PG8_BAR __builtin_amdgcn_s_barrier()
#define PG8_SCHED __builtin_amdgcn_sched_barrier(0)
    Unit cur, nxt; int ui = 0;
    if (!S.next(0, cur)) return;
    f32x4 acc[2][2][4][2];
#pragma unroll
    for (int a = 0; a < 2; ++a)
#pragma unroll
        for (int b = 0; b < 2; ++b)
#pragma unroll
            for (int m = 0; m < 4; ++m)
#pragma unroll
                for (int n = 0; n < 2; ++n) acc[a][b][m][n] = (f32x4){0.f, 0.f, 0.f, 0.f};
    bf16x8 At[4][2], B0[2][2], B1[2][2];
    const char* cA = (const char*)g.A + (size_t)cur.pm * tA + (size_t)cur.pn * g.a_pn_off * 2; const char* cB = (const char*)g.Bt + (size_t)cur.pn * tB;
    PG8_STAGE(PG8_SB(0, 0), cB, voffB); PG8_STAGE(PG8_SB(0, 1), cB + hB, voffB); PG8_STAGE(PG8_SA(0, 0), cA, voffA); PG8_STAGE(PG8_SA(0, 1), cA + hA, voffA);
    if (wr == 1) PG8_BAR;
    PG8_WAIT_V(2); PG8_BAR;
    PG8_STAGE(PG8_SB(1, 0), cB + kstep, voffB); PG8_STAGE(PG8_SA(1, 0), cA + kstep, voffA); PG8_STAGE(PG8_SB(1, 1), cB + hB + kstep, voffB);
    PG8_WAIT_V(6); PG8_BAR;
    for (;;) {
        const bool has_next = S.next(ui + 1, nxt);
        const char* nA = has_next ? (const char*)g.A + (size_t)nxt.pm * tA + (size_t)nxt.pn * g.a_pn_off * 2 : cA; const char* nB = has_next ? (const char*)g.Bt + (size_t)nxt.pn * tB : cB;
        for (int t = 0; t < nt; t += 2) {
            const bool last = (t == nt - 2);
            const char* a1 = cA + (size_t)(t + 1) * kstep;
            const char* a2 = last ? nA : cA + (size_t)(t + 2) * kstep; const char* b2 = last ? nB : cB + (size_t)(t + 2) * kstep;
            const char* a3 = a2 + kstep; const char* b3 = b2 + kstep;
            PG8_LDB(B0, 0, 0); PG8_LDB(B1, 0, 1); PG8_SCHED; PG8_LDA(At, 0, 0); PG8_STAGE(PG8_SA(1, 1), a1 + hA, voffA);
            PG8_WAIT_V(8); PG8_WAIT_L(0); PG8_BAR; PG8_MMA(0, 0, At, B0); PG8_MMA(0, 1, At, B1); PG8_BAR; PG8_SCHED;
            PG8_LDA(At, 0, 1); PG8_STAGE(PG8_SB(0, 0), b2, voffB); PG8_STAGE(PG8_SB(0, 1), b2 + hB, voffB); PG8_STAGE(PG8_SA(0, 0), a2, voffA);
            PG8_WAIT_V(8); PG8_WAIT_L(0); PG8_BAR; PG8_MMA(1, 0, At, B0); PG8_MMA(1, 1, At, B1); PG8_BAR; PG8_SCHED;
            PG8_LDB(B0, 1, 0); PG8_LDB(B1, 1, 1); PG8_SCHED; PG8_LDA(At, 1, 0); PG8_STAGE(PG8_SA(0, 1), a2 + hA, voffA);
            PG8_WAIT_V(8); PG8_WAIT_L(0); PG8_BAR; PG8_MMA(0, 0, At, B0); PG8_MMA(0, 1, At, B1); PG8_BAR; PG8_SCHED;
            PG8_LDA(At, 1, 1); PG8_STAGE(PG8_SB(1, 0), b3, voffB); PG8_STAGE(PG8_SB(1, 1), b3 + hB, voffB); PG8_STAGE(PG8_SA(1, 0), a3, voffA);
            PG8_WAIT_V(8); PG8_WAIT_L(0); PG8_BAR; PG8_MMA(1, 0, At, B0); PG8_MMA(1, 1, At, B1); PG8_BAR; PG8_SCHED;
        }
        if (wr == 0) PG8_BAR;
        E(acc, cur, wr, wc, fr, fq);
        if (!has_next) break;
#pragma unroll
        for (int a = 0; a < 2; ++a)
#pragma unroll
            for (int b = 0; b < 2; ++b)
#pragma unroll
                for (int m = 0; m < 4; ++m)
#pragma unroll
                    for (int n = 0; n < 2; ++n) acc[a][b][m][n] = (f32x4){0.f, 0.f, 0.f, 0.f};
        cur = nxt; cA = nA; cB = nB; ++ui;
        if (wr == 1) PG8_BAR;
    }
    PG8_WAIT_V(0);
    PG8_BAR;
#undef PG8_SA
#undef PG8_SB
#undef PG8_STAGE
#undef PG8_LDA
#undef PG8_LDB
#undef PG8_MMA
#undef PG8_WAIT_V
#undef PG8_WAIT_L
#undef PG8_BAR
#undef PG8_SCHED
}

struct EpiB2 {
    static constexpr bool PERM = true;
    bf16_t* O0; int ld0; bf16_t* O1; int ld1; int split; float scale;
    DI void operator()(const f32x4 (&acc)[2][2][4][2], const Unit& u, int wr, int wc, int fr, int fq) const {
        const int row0 = u.pm * BM + wr * 64 + fr;
        bf16_t* base; int ld, colt;
        if (u.pn < split) { base = O0; ld = ld0; colt = u.pn * BM; } else { base = O1; ld = ld1; colt = (u.pn - split) * BM; }
        const int col0 = colt + wc * 32 + 8 * fq;
#pragma unroll
        for (int ai = 0; ai < 2; ++ai)
#pragma unroll
            for (int m = 0; m < 4; ++m) { bf16_t* rowp = base + (size_t)(row0 + ai * HALF + m * 16) * ld + col0;
#pragma unroll
                for (int bj = 0; bj < 2; ++bj) { const f32x4 v0 = acc[ai][bj][m][0] * scale, v1 = acc[ai][bj][m][1] * scale;
                    u32x4 w; w.x = cvt_pk_bf16(v0[0], v0[1]); w.y = cvt_pk_bf16(v0[2], v0[3]); w.z = cvt_pk_bf16(v1[0], v1[1]); w.w = cvt_pk_bf16(v1[2], v1[3]);
                    *(u32x4*)(rowp + bj * HALF) = w; } }
    }
};
struct EpiSilu {
    static constexpr bool PERM = true;
    bf16_t* O; int ldc; const bf16_t* Z; int ldz;
    DI void operator()(const f32x4 (&acc)[2][2][4][2], const Unit& u, int wr, int wc, int fr, int fq) const {
        const int row0 = u.pm * BM + wr * 64 + fr, col0 = u.pn * BM + wc * 32 + 8 * fq;
#pragma unroll
        for (int ai = 0; ai < 2; ++ai)
#pragma unroll
            for (int m = 0; m < 4; ++m) { const size_t r = (size_t)(row0 + ai * HALF + m * 16);
#pragma unroll
                for (int bj = 0; bj < 2; ++bj) { const u32x4 zz = *(const u32x4*)(Z + r * ldz + col0 + bj * HALF);
                    const f32x4 a0 = acc[ai][bj][m][0], a1 = acc[ai][bj][m][1];
                    u32x4 w; w.x = cvt_pk_bf16(a0[0] * siluf(bflo(zz.x)), a0[1] * siluf(bfhi(zz.x))); w.y = cvt_pk_bf16(a0[2] * siluf(bflo(zz.y)), a0[3] * siluf(bfhi(zz.y)));
                    w.z = cvt_pk_bf16(a1[0] * siluf(bflo(zz.z)), a1[1] * siluf(bfhi(zz.z))); w.w = cvt_pk_bf16(a1[2] * siluf(bflo(zz.w)), a1[3] * siluf(bfhi(zz.w)));
                    *(u32x4*)(O + r * ldc + col0 + bj * HALF) = w; } }
    }
};
struct EpiRes {
    static constexpr bool PERM = false;
    const float* base; float* out; int ldc; float alpha;
    DI void operator()(const f32x4 (&acc)[2][2][4][2], const Unit& u, int wr, int wc, int fr, int fq) const {
        const int row0 = u.pm * BM + wr * 64 + fr, col0 = u.pn * BM + wc * 32 + 4 * fq;
#pragma unroll
        for (int ai = 0; ai < 2; ++ai)
#pragma unroll
            for (int m = 0; m < 4; ++m) { const size_t off = (size_t)(row0 + ai * HALF + m * 16) * ldc + col0;
#pragma unroll
                for (int bj = 0; bj < 2; ++bj)
#pragma unroll
                    for (int n = 0; n < 2; ++n) { const f32x4 bs = *(const f32x4*)(base + off + bj * HALF + n * 16); *(f32x4*)(out + off + bj * HALF + n * 16) = bs * alpha + acc[ai][bj][m][n]; }
                asm volatile("" ::: "memory"); }
    }
};
struct EpiGate {
    static constexpr bool PERM = true;
    bf16_t* HH; const float* ssq; const float* hg;
    DI void operator()(const f32x4 (&acc)[2][2][4][2], const Unit& u, int wr, int wc, int fr, int fq) const {
        const int row0 = u.pm * BM + wr * 64 + fr, col0 = u.pn * 128 + wc * 32 + 8 * fq, head = u.pn >> 2;
        const f32x4 g0 = *(const f32x4*)(hg + col0), g1 = *(const f32x4*)(hg + col0 + 4);
#pragma unroll
        for (int ai = 0; ai < 2; ++ai)
#pragma unroll
            for (int m = 0; m < 4; ++m) { const size_t r = (size_t)(row0 + ai * HALF + m * 16);
                const f32x4* sp = (const f32x4*)(ssq + (r * 4 + head) * 32);
                f32x4 s4 = sp[0];
#pragma unroll
                for (int q = 1; q < 8; ++q) s4 += sp[q];
                const float rs = __builtin_amdgcn_rsqf((s4[0] + s4[1] + s4[2] + s4[3]) * (1.f / 512.f) + LN_EPS);
                const u32x4 hh = *(const u32x4*)(HH + r * 2048 + col0);
                const f32x4 o0 = acc[ai][0][m][0], o1 = acc[ai][0][m][1], z0 = acc[ai][1][m][0], z1 = acc[ai][1][m][1];
                u32x4 w;
                w.x = cvt_pk_bf16(bflo(hh.x) * rs * g0[0] * sigmf(o0[0]) * siluf(z0[0]), bfhi(hh.x) * rs * g0[1] * sigmf(o0[1]) * siluf(z0[1]));
                w.y = cvt_pk_bf16(bflo(hh.y) * rs * g0[2] * sigmf(o0[2]) * siluf(z0[2]), bfhi(hh.y) * rs * g0[3] * sigmf(o0[3]) * siluf(z0[3]));
                w.z = cvt_pk_bf16(bflo(hh.z) * rs * g1[0] * sigmf(o1[0]) * siluf(z1[0]), bfhi(hh.z) * rs * g1[1] * sigmf(o1[1]) * siluf(z1[1]));
                w.w = cvt_pk_bf16(bflo(hh.w) * rs * g1[2] * sigmf(o1[2]) * siluf(z1[2]), bfhi(hh.w) * rs * g1[3] * sigmf(o1[3]) * siluf(z1[3]));
                *(u32x4*)(HH + r * 2048 + col0) = w; }
    }
};
}

#define XB_TMO      128
#define XB_XCNT(j)  (256  + 64 * (j))
#define XB_XSUB(j)  (1280 + 64 * (j))
#define XB_XGEN(j)  (2304 + 64 * (j))
#define XB_TOP      3328
#define XB_TOPGEN   3392
#define XCD_BAR_WORDS 3456
#define XB_SPIN_CAP (1u << 18)
DI unsigned xb_ld(unsigned* p)              { return __hip_atomic_load(p, __ATOMIC_RELAXED, __HIP_MEMORY_SCOPE_AGENT); }
DI unsigned xb_add(unsigned* p, unsigned v) { return __hip_atomic_fetch_add(p, v, __ATOMIC_RELAXED, __HIP_MEMORY_SCOPE_AGENT); }
DI unsigned xb_xcc_id() { return (unsigned)__builtin_amdgcn_s_getreg((3 << 11) | 20) & 0xFu; }
#define XB_SPIN(cond, bar) do { unsigned _sp = 0; while (cond) { __builtin_amdgcn_s_sleep(1); \
    if ((++_sp & 255u) == 0u) { if (xb_ld(&(bar)[XB_TMO])) break; if (_sp > XB_SPIN_CAP) { atomicAdd(&(bar)[XB_TMO], 1u); break; } } } } while (0)
struct XcdBarrier { unsigned* bar; unsigned x; volatile LAS unsigned* st; };
DI XcdBarrier xcd_barrier_post(unsigned* bar, volatile LAS unsigned* st) {
    XcdBarrier b; b.bar = bar; b.x = xb_xcc_id(); b.st = st;
    if (threadIdx.x == 0) (void)xb_add(&bar[XB_XCNT(b.x)], 1u);
    return b;
}
DI void xcd_barrier_complete(unsigned* bar, unsigned x, unsigned& nloc, unsigned& nx) {
    const unsigned G = gridDim.x * gridDim.y * gridDim.z;
    unsigned sum, cnt, mine, sp = 0u;
    for (;;) {
        sum = 0u; cnt = 0u; mine = 0u;
#pragma unroll
        for (unsigned j = 0; j < 16; ++j) { const unsigned c = xb_ld(&bar[XB_XCNT(j)]); sum += c; cnt += (c > 0u) ? 1u : 0u; mine = (j == x) ? c : mine; }
        if (sum == G) break;
        __builtin_amdgcn_s_sleep(1);
        if ((++sp & 255u) == 0u) { if (xb_ld(&bar[XB_TMO])) break; if (sp > XB_SPIN_CAP) { atomicAdd(&bar[XB_TMO], 1u); break; } }
    }
    nloc = mine > 0u ? mine : 1u; nx = cnt > 0u ? cnt : 1u;
}
DI void xcd_barrier(const XcdBarrier& b) {
    asm volatile("s_waitcnt vmcnt(0)" ::: "memory");
    __syncthreads();
    if (threadIdx.x == 0) {
        unsigned* bar = b.bar;
        __builtin_amdgcn_s_waitcnt(0);
        unsigned nloc = b.st[0], nx = b.st[1];
        if (nloc == 0u) { xcd_barrier_complete(bar, b.x, nloc, nx); b.st[0] = nloc; b.st[1] = nx; }
        const unsigned old = xb_add(&bar[XB_XSUB(b.x)], 1u);
        const unsigned gen = old / nloc;
        if (old + 1u == (gen + 1u) * nloc) {
            __builtin_amdgcn_fence(__ATOMIC_RELEASE, "agent");
            asm volatile("s_waitcnt vmcnt(0)" ::: "memory");
            const unsigned og = xb_add(&bar[XB_TOP], 1u);
            const unsigned tg = og / nx;
            if (og + 1u == (tg + 1u) * nx) xb_add(&bar[XB_TOPGEN], 1u);
            else XB_SPIN(xb_ld(&bar[XB_TOPGEN]) == tg, bar);
            __builtin_amdgcn_fence(__ATOMIC_ACQUIRE, "agent");
            xb_add(&bar[XB_XGEN(b.x)], 1u);
            asm volatile("s_waitcnt vmcnt(0)" ::: "memory");
        } else {
            XB_SPIN(xb_ld(&bar[XB_XGEN(b.x)]) == gen, bar);
            __builtin_amdgcn_fence(__ATOMIC_ACQUIRE, "agent");
            asm volatile("s_waitcnt vmcnt(0)" ::: "memory");
        }
    }
    __syncthreads();
}

struct Frame {
    LAS unsigned char* lds;
    int tid, lane, wave, G;
    const float *x, *a_w_in, *a_kv_g, *a_w_uk, *a_w_uv, *a_w_out, *a_ln_g, *a_ln_b;
    const float *b_w_in, *b_i_bias, *b_f_bias, *b_conv_w, *b_conv_b, *b_hn_g, *b_w_out, *b_ln_g, *b_ln_b;
    float* out; unsigned char* ws;
};

DI void p0_item(const float* W, int ldw, int c0, int nvalid, bf16* WT, int ldt, int drow, int dcol0, LAS float* scr, int k0, int n0, int lane) {
    const bool ok = (n0 + (lane & 31)) < nvalid;
#pragma unroll 8
    for (int i = 0; i < 32; ++i) { const int kk = 2 * i + (lane >> 5); scr[kk * 33 + (lane & 31)] = ok ? W[(size_t)(k0 + kk) * ldw + c0 + n0 + (lane & 31)] : 0.f; }
    LDS_WAIT(); asm volatile("" ::: "memory");
    const int c = lane & 7;
#pragma unroll
    for (int j = 0; j < 4; ++j) { const int n = (lane >> 3) + 8 * j; const LAS float* s = scr + (8 * c) * 33 + n;
        u32x4 o; o.x = pk2(s[0 * 33], s[1 * 33]); o.y = pk2(s[2 * 33], s[3 * 33]); o.z = pk2(s[4 * 33], s[5 * 33]); o.w = pk2(s[6 * 33], s[7 * 33]);
        *(u32x4*)(WT + (size_t)(drow + n) * ldt + dcol0 + k0 + 8 * c) = o; }
    LDS_WAIT(); asm volatile("" ::: "memory");
}
DI void p0_prologue(Frame& F) {
    LAS float* scr = (LAS float*)(F.lds + F.wave * 16384);
    const int gw = blockIdx.x * 8 + F.wave, NGW = F.G * 8, lane = F.lane;
    bf16* WA = (bf16*)(F.ws + WS_WA); bf16* WUK = (bf16*)(F.ws + WS_WUK); bf16* WUVB = (bf16*)(F.ws + WS_WUVB); bf16* WAO = (bf16*)(F.ws + WS_WAO);
    bf16* WBI = (bf16*)(F.ws + WS_WBI); bf16* WBO = (bf16*)(F.ws + WS_WBO);
    constexpr int I0 = 16 * 64, I1 = 16 * 32, I2 = 128, I3 = 128, I4 = 16 * 32, I5 = 16 * 128, I6 = 16 * 64, I7 = 16 * 64, I8 = 32 * 32;
    constexpr int NIT = I0 + I1 + I2 + I3 + I4 + I5 + I6 + I7 + I8;
    for (int it = gw; it < NIT; it += NGW) {
        int r = it;
        if (r < I0) { const int kb = r / 64, nb = r % 64; p0_item(F.a_w_in, A_IN, 0, 1864, WA, 1024, 32 * nb, 0, scr, 64 * kb, 32 * nb, lane); continue; } r -= I0;
        if (r < I1) { const int kb = r / 32, nb = r % 32; p0_item(F.a_w_in, A_IN, 1864, 1024, WA, 1024, 2048 + 32 * nb, 0, scr, 64 * kb, 32 * nb, lane); continue; } r -= I1;
        if (r < I2) { const int h = r / 16, q = r % 16, kb = q / 8, nb = q % 8; p0_item(F.a_w_uk + (size_t)h * 128 * 256, 256, 0, 256, WUK, 128, h * 256 + 32 * nb, 0, scr, 64 * kb, 32 * nb, lane); continue; } r -= I2;
        if (r < I3) { const int h = r / 16, q = r % 16, kb = q / 4, nb = q % 4; p0_item(F.a_w_uv + (size_t)h * 256 * 128, 128, 0, 128, WUVB, 512, h * 128 + 32 * nb, (h & 1) * 256, scr, 64 * kb, 32 * nb, lane); continue; } r -= I3;
        if (r < I4) { const int kb = r / 32, nb = r % 32; p0_item(F.a_w_out, 1024, 0, 1024, WAO, 1024, 32 * nb, 0, scr, 64 * kb, 32 * nb, lane); continue; } r -= I4;
        if (r < I5) { const int kb = r / 128, nb = r % 128; p0_item(F.b_w_in, B_IN, 0, 4096, WBI, 1024, 32 * nb, 0, scr, 64 * kb, 32 * nb, lane); continue; } r -= I5;
        if (r < I6) { const int kb = r / 64, nb = r % 64; p0_item(F.b_w_in, B_IN, 4104, 2048, WBI, 1024, 4096 + 256 * (nb >> 2) + 32 * (nb & 3), 0, scr, 64 * kb, 32 * nb, lane); continue; } r -= I6;
        if (r < I7) { const int kb = r / 64, nb = r % 64; p0_item(F.b_w_in, B_IN, 6152, 2048, WBI, 1024, 4096 + 256 * (nb >> 2) + 128 + 32 * (nb & 3), 0, scr, 64 * kb, 32 * nb, lane); continue; } r -= I7;
        { const int kb = r / 32, nb = r % 32; p0_item(F.b_w_out, 1024, 0, 1024, WBO, 2048, 32 * nb, 0, scr, 64 * kb, 32 * nb, lane); }
    }
    const size_t gt = (size_t)blockIdx.x * 512 + F.tid, NT = (size_t)F.G * 512;
    for (size_t i = gt; i < 1024 * 32; i += NT) { const int n = (int)(i >> 5), c = (int)(i & 31), h = n >> 7; *(u32x4*)(WUVB + (size_t)n * 512 + ((h & 1) ^ 1) * 256 + c * 8) = (u32x4){0u, 0u, 0u, 0u}; }
    float* WGp = (float*)(F.ws + WS_WG);
    for (size_t i = gt; i < 8 * 1024; i += NT) { const int j = (int)(i >> 10), k = (int)(i & 1023); WGp[i] = F.b_w_in[(size_t)k * B_IN + 4096 + j]; }
    bf16* XB = (bf16*)(F.ws + WS_XB);
    for (size_t i = gt; i < (size_t)M * D / 8; i += NT) { const f32x4 a = *(const f32x4*)(F.x + i * 8), b = *(const f32x4*)(F.x + i * 8 + 4);
        u32x4 o; o.x = pk2(a[0], a[1]); o.y = pk2(a[2], a[3]); o.z = pk2(b[0], b[1]); o.w = pk2(b[2], b[3]); *(u32x4*)(XB + i * 8) = o; }
}

DI void p2_ckv(Frame& F) {
    const bf16* PA1 = (const bf16*)(F.ws + WS_PA1); bf16* CKV = (bf16*)(F.ws + WS_CKV);
    const int gw = blockIdx.x * 8 + F.wave, NGW = F.G * 8, lane = F.lane;
    const f32x4 g = *(const f32x4*)(F.a_kv_g + lane * 4);
    for (int tok = gw; tok < M; tok += NGW) {
        const u32x2 raw = *(const u32x2*)(PA1 + (size_t)tok * 2048 + 1024 + lane * 4);
        const float v0 = bflo(raw.x), v1 = bfhi(raw.x), v2 = bflo(raw.y), v3 = bfhi(raw.y);
        const float ss = wave_sum(v0 * v0 + v1 * v1 + v2 * v2 + v3 * v3);
        const float r = 1.f / sqrtf(ss * (1.f / 256.f) + LN_EPS);
        u32x2 o; o.x = pk2(v0 * r * g[0], v1 * r * g[1]); o.y = pk2(v2 * r * g[2], v3 * r * g[3]);
        *(u32x2*)(CKV + (size_t)tok * 256 + lane * 4) = o;
    }
}

DI void p3_index_topk(Frame& F) {
    const bf16* PA1 = (const bf16*)(F.ws + WS_PA1); short* SEL = (short*)(F.ws + WS_SEL);
    LAS float* S = (LAS float*)F.lds;
    LAS short* sb = (LAS short*)(F.lds + AUX_OFF) + F.wave * 256;
    const int lane = F.lane, wave = F.wave, fr = lane & 15, fq = lane >> 4;
    const unsigned long long lt_mask = (1ull << lane) - 1ull;
    for (int idx = blockIdx.x; idx < 2048; idx += F.G) {
        const int i = idx >> 8, w = idx & 255, b = i >> 1, r = (i & 1) ? (511 - w) : w;
        const int t0 = r * 8, tok0 = b * T + t0;
        bf16x8 af[4][2]; float wv[4][4];
#pragma unroll
        for (int m = 0; m < 4; ++m) {
#pragma unroll
            for (int ks = 0; ks < 2; ++ks) af[m][ks] = *(const bf16x8*)(PA1 + (size_t)(tok0 + 2 * m + (fr >> 3)) * 2048 + 1280 + (fr & 7) * 64 + ks * 32 + fq * 8);
            const u32x2 raw = *(const u32x2*)(PA1 + (size_t)(tok0 + 2 * m + (fq >> 1)) * 2048 + 1856 + 4 * (fq & 1));
            wv[m][0] = bflo(raw.x); wv[m][1] = bfhi(raw.x); wv[m][2] = bflo(raw.y); wv[m][3] = bfhi(raw.y);
        }
        const int nkt = (t0 + 8 + 15) >> 4;
        for (int kt = wave; kt < nkt; kt += 8) {
            const bf16* kp = PA1 + (size_t)(b * T + kt * 16 + fr) * 2048 + 1792 + fq * 8;
            const bf16x8 b0 = *(const bf16x8*)kp, b1 = *(const bf16x8*)(kp + 32);
#pragma unroll
            for (int m = 0; m < 4; ++m) {
                f32x4 acc = (f32x4){0.f, 0.f, 0.f, 0.f};
                acc = __builtin_amdgcn_mfma_f32_16x16x32_bf16(af[m][0], b0, acc, 0, 0, 0);
                acc = __builtin_amdgcn_mfma_f32_16x16x32_bf16(af[m][1], b1, acc, 0, 0, 0);
                float s = wv[m][0] * fmaxf(acc[0], 0.f) + wv[m][1] * fmaxf(acc[1], 0.f) + wv[m][2] * fmaxf(acc[2], 0.f) + wv[m][3] * fmaxf(acc[3], 0.f);
                s += __shfl_xor(s, 16);
                if ((fq & 1) == 0) S[(2 * m + (fq >> 1)) * 4096 + kt * 16 + fr] = s;
            }
        }
        __syncthreads();
        {
            const int t = t0 + wave;
            unsigned key[64];
#pragma unroll
            for (int j = 0; j < 64; ++j) { const int s = j * 64 + lane; const float v = S[wave * 4096 + s] + 0.0f; unsigned u = __float_as_uint(v); u = (u & 0x80000000u) ? ~u : (u | 0x80000000u); key[j] = (s <= t) ? u : 0u; }
            unsigned Tk = 0u;
            for (int bit = 31; bit >= 0; --bit) {
                const unsigned cand = Tk | (1u << bit);
                int cnt = 0;
#pragma unroll
                for (int j = 0; j < 64; ++j) cnt += (key[j] >= cand) ? 1 : 0;
                if (wave_sum_small(cnt) >= 256) Tk = cand;
            }
            int cg = 0, ce = 0;
#pragma unroll
            for (int j = 0; j < 64; ++j) { cg += (key[j] > Tk) ? 1 : 0; ce += (key[j] == Tk) ? 1 : 0; }
            const int cgt = wave_sum_small(cg);
            const int nties = (Tk != 0u) ? (256 - cgt) : 0;
            int pos = cg;
#pragma unroll
            for (int d = 1; d < 64; d <<= 1) { const int tv = __shfl_up(pos, d); if (lane >= d) pos += tv; }
            pos -= cg;
#pragma unroll
            for (int j = 0; j < 64; ++j) { if (key[j] > Tk) { sb[pos] = (short)(j * 64 + lane); ++pos; } }
            if (nties > 0) {
                int base_eq = 0;
#pragma unroll 1
                for (int j = 0; j < 64; ++j) {
                    const int s = j * 64 + lane; const float v = S[wave * 4096 + s] + 0.0f; unsigned u = __float_as_uint(v); u = (u & 0x80000000u) ? ~u : (u | 0x80000000u);
                    const bool eq = (s <= t) && (u == Tk);
                    const unsigned long long me = __ballot(eq);
                    if (me != 0ull) {
                        const int pe = base_eq + __popcll(me & lt_mask);
                        if (eq && pe < nties) sb[cgt + pe] = (short)s;
                        base_eq += __popcll(me);
                        if (base_eq >= nties) break;
                    }
                }
            }
            const int total = cgt + nties;
            for (int p = total + lane; p < 256; p += 64) sb[p] = (short)-1;
            LDS_WAIT(); asm volatile("" ::: "memory");
            const u32x2 o = *(const LAS u32x2*)(sb + 4 * lane);
            *(u32x2*)(SEL + (size_t)(tok0 + wave) * 256 + 4 * lane) = o;
        }
        __syncthreads();
    }
}

DI int cimg(int row, int piece) { return row * 512 + ((piece ^ ((row & 7) << 1)) << 4); }
DI void p4_attention(Frame& F) {
    const bf16* CKV = (const bf16*)(F.ws + WS_CKV); const bf16* QLAT = (const bf16*)(F.ws + WS_QLAT); const short* SEL = (const short*)(F.ws + WS_SEL);
    bf16* OLAT = (bf16*)(F.ws + WS_PA1);
    const int lane = F.lane, wave = F.wave, fr = lane & 15, fq = lane >> 4;
    LAS unsigned char* img = F.lds + wave * 16384;
    LAS short* sb = (LAS short*)(F.lds + AUX_OFF) + wave * 256;
    const float slope = (fr < 8) ? exp2f(-(float)(fr + 1)) : 0.f;
    const int NW = F.G * 8;
    for (int it = 0; it < (M + NW - 1) / NW; ++it) {
        int tok;
        if (F.G == 256) { const int xcd = blockIdx.x & 7, b = xcd >> 1, ib = (blockIdx.x >> 3) * 2 + (xcd & 1); tok = b * T + (ib * 8 + wave) + 512 * it; }
        else tok = (blockIdx.x * 8 + wave) + NW * it;
        if (tok >= M) break;
        const int b = tok / T, t = tok % T;
        bf16x8 bq[8];
#pragma unroll
        for (int ks = 0; ks < 8; ++ks) bq[ks] = (fr < 8) ? *(const bf16x8*)(QLAT + (size_t)tok * 2048 + fr * 256 + ks * 32 + fq * 8) : (bf16x8){0, 0, 0, 0, 0, 0, 0, 0};
        { const u32x2 sv = *(const u32x2*)(SEL + (size_t)tok * 256 + 4 * lane); *(LAS u32x2*)(sb + 4 * lane) = sv; }
        LDS_WAIT(); asm volatile("" ::: "memory");
        const int nvalid = (t + 1 < 256) ? (t + 1) : 256;
        const int nch = (nvalid + 31) >> 5;
        f32x4 oacc[16];
#pragma unroll
        for (int n = 0; n < 16; ++n) oacc[n] = (f32x4){0.f, 0.f, 0.f, 0.f};
        float m_run = -INFINITY, l_run = 0.f;
        for (int ch = 0; ch < nch; ++ch) {
#pragma unroll
            for (int hb = 0; hb < 2; ++hb) {
                u32x4 v[8];
#pragma unroll
                for (int rr = 0; rr < 8; ++rr) { const int row = 16 * hb + 2 * rr + (lane >> 5); int kid = sb[32 * ch + row]; kid = kid < 0 ? 0 : kid;
                    v[rr] = *(const u32x4*)(CKV + (size_t)(b * T + kid) * 256 + (lane & 31) * 8); }
#pragma unroll
                for (int rr = 0; rr < 8; ++rr) { const int row = 16 * hb + 2 * rr + (lane >> 5); *(LAS u32x4*)(img + cimg(row, lane & 31)) = v[rr]; }
            }
            LDS_WAIT(); asm volatile("" ::: "memory");
            f32x4 lg[2];
#pragma unroll
            for (int tt = 0; tt < 2; ++tt) {
                f32x4 acc = (f32x4){0.f, 0.f, 0.f, 0.f};
#pragma unroll
                for (int ks = 0; ks < 8; ++ks) { const bf16x8 a = *(const LAS bf16x8*)(img + cimg(16 * tt + fr, 4 * ks + fq)); acc = __builtin_amdgcn_mfma_f32_16x16x32_bf16(a, bq[ks], acc, 0, 0, 0); }
                const s16x4 kp = *(const LAS s16x4*)(sb + 32 * ch + 16 * tt + 4 * fq);
#pragma unroll
                for (int rg = 0; rg < 4; ++rg) { const int kid = kp[rg]; acc[rg] = (kid >= 0) ? (acc[rg] - slope * (float)(t - kid)) : -INFINITY; }
                lg[tt] = acc;
            }
            float cmax = fmaxf(fmaxf(fmaxf(lg[0][0], lg[0][1]), fmaxf(lg[0][2], lg[0][3])), fmaxf(fmaxf(lg[1][0], lg[1][1]), fmaxf(lg[1][2], lg[1][3])));
            cmax = fmaxf(cmax, __shfl_xor(cmax, 16)); cmax = fmaxf(cmax, __shfl_xor(cmax, 32));
            const float m_new = fmaxf(m_run, cmax);
            const float alpha = __expf(m_run - m_new);
            float p[8]; float ps = 0.f;
#pragma unroll
            for (int tt = 0; tt < 2; ++tt)
#pragma unroll
                for (int rg = 0; rg < 4; ++rg) { p[tt * 4 + rg] = __expf(lg[tt][rg] - m_new); ps += p[tt * 4 + rg]; }
            ps += __shfl_xor(ps, 16); ps += __shfl_xor(ps, 32);
            l_run = l_run * alpha + ps; m_run = m_new;
            float ah[4];
#pragma unroll
            for (int rg = 0; rg < 4; ++rg) ah[rg] = __shfl(alpha, 4 * fq + rg);
#pragma unroll
            for (int n = 0; n < 16; ++n) { oacc[n][0] *= ah[0]; oacc[n][1] *= ah[1]; oacc[n][2] *= ah[2]; oacc[n][3] *= ah[3]; }
            bf16x8 pa;
            { const unsigned w0 = pk2(p[0], p[1]), w1 = pk2(p[2], p[3]), w2 = pk2(p[4], p[5]), w3 = pk2(p[6], p[7]);
              pa = __builtin_bit_cast(bf16x8, (u32x4){w0, w1, w2, w3}); }
            const int q4 = (lane & 15) >> 2, p4 = lane & 3;
#pragma unroll
            for (int n = 0; n < 16; ++n) {
                const int rlo = 4 * fq + q4, rhi = 16 + 4 * fq + q4, piece = 2 * n + (p4 >> 1);
                const s16x4 lo = __builtin_amdgcn_ds_read_tr16_b64_v4i16((LAS s16x4*)(img + cimg(rlo, piece) + 8 * (p4 & 1)));
                const s16x4 hi = __builtin_amdgcn_ds_read_tr16_b64_v4i16((LAS s16x4*)(img + cimg(rhi, piece) + 8 * (p4 & 1)));
                const bf16x8 bv = (bf16x8){lo[0], lo[1], lo[2], lo[3], hi[0], hi[1], hi[2], hi[3]};
                oacc[n] = __builtin_amdgcn_mfma_f32_16x16x32_bf16(pa, bv, oacc[n], 0, 0, 0);
            }
            LDS_WAIT(); asm volatile("" ::: "memory");
        }
        float lh[4];
#pragma unroll
        for (int rg = 0; rg < 4; ++rg) lh[rg] = 1.f / __shfl(l_run, 4 * fq + rg);
        if (fq < 2) {
#pragma unroll
            for (int n = 0; n < 16; ++n)
#pragma unroll
                for (int rg = 0; rg < 4; ++rg) ((LAS bf16*)img)[(4 * fq + rg) * 256 + 16 * n + fr] = (bf16)f2bf(oacc[n][rg] * lh[rg]);
        }
        LDS_WAIT(); asm volatile("" ::: "memory");
#pragma unroll
        for (int q = 0; q < 4; ++q) { const u32x4 v = *(const LAS u32x4*)(img + (q * 64 + lane) * 16); *(u32x4*)(OLAT + (size_t)tok * 2048 + (q * 64 + lane) * 8) = v; }
        LDS_WAIT(); asm volatile("" ::: "memory");
    }
}

template <bool FIRST>
DI void p_ln_rows(Frame& F, const float* gam, const float* bet) {
    float* U = F.out; bf16* X1B = (bf16*)(F.ws + WS_XB); const float* WGp = (const float*)(F.ws + WS_WG); float* GATES = (float*)(F.ws + WS_GATES);
    const int gw = blockIdx.x * 8 + F.wave, NGW = F.G * 8, lane = F.lane;
    f32x4 gv[4], bv[4];
#pragma unroll
    for (int j = 0; j < 4; ++j) { gv[j] = *(const f32x4*)(gam + 4 * lane + 256 * j); bv[j] = *(const f32x4*)(bet + 4 * lane + 256 * j); }
    for (int tok = gw; tok < M; tok += NGW) {
        f32x4 v[4]; float s = 0.f;
#pragma unroll
        for (int j = 0; j < 4; ++j) { v[j] = *(const f32x4*)(U + (size_t)tok * D + 4 * lane + 256 * j); s += (v[j][0] + v[j][1]) + (v[j][2] + v[j][3]); }
        const float mean = wave_sum(s) * (1.f / D); float s2 = 0.f;
#pragma unroll
        for (int j = 0; j < 4; ++j) { v[j] = v[j] - mean; s2 += (v[j][0] * v[j][0] + v[j][1] * v[j][1]) + (v[j][2] * v[j][2] + v[j][3] * v[j][3]); }
        const float rstd = 1.f / sqrtf(wave_sum(s2) * (1.f / D) + LN_EPS);
#pragma unroll
        for (int j = 0; j < 4; ++j) { v[j] = v[j] * rstd * gv[j] + bv[j]; *(f32x4*)(U + (size_t)tok * D + 4 * lane + 256 * j) = v[j]; }
        if (FIRST) {
#pragma unroll
            for (int j = 0; j < 4; ++j) { u32x2 o; o.x = pk2(v[j][0], v[j][1]); o.y = pk2(v[j][2], v[j][3]); *(u32x2*)(X1B + (size_t)tok * D + 4 * lane + 256 * j) = o; }
            float gsum = 0.f;
#pragma unroll
            for (int jg = 0; jg < 8; ++jg) { float d = 0.f;
#pragma unroll
                for (int j = 0; j < 4; ++j) { const f32x4 w = *(const f32x4*)(WGp + jg * 1024 + 4 * lane + 256 * j); d += (v[j][0] * w[0] + v[j][1] * w[1]) + (v[j][2] * w[2] + v[j][3] * w[3]); }
                d = wave_sum(d); gsum = (lane == jg) ? d : gsum; }
            if (lane < 8) GATES[(size_t)tok * 8 + lane] = gsum;
        }
    }
}

constexpr int QS_STRIDE = 272;
DI float block_scan_add(float v, LAS float* wtot, int lane, int wave) {
#pragma unroll
    for (int d = 1; d < 64; d <<= 1) { const float t = __shfl_up(v, d); if (lane >= d) v += t; }
    if (lane == 63) wtot[wave] = v;
    __syncthreads();
    float off = 0.f;
#pragma unroll
    for (int w = 0; w < 8; ++w) off += (w < wave) ? wtot[w] : 0.f;
    __syncthreads();
    return v + off;
}
DI float block_scan_max(float v, LAS float* wtot, int lane, int wave) {
#pragma unroll
    for (int d = 1; d < 64; d <<= 1) { const float t = __shfl_up(v, d); if (lane >= d) v = fmaxf(v, t); }
    if (lane == 63) wtot[wave] = v;
    __syncthreads();
    float off = -INFINITY;
#pragma unroll
    for (int w = 0; w < 8; ++w) off = (w < wave) ? fmaxf(off, wtot[w]) : off;
    __syncthreads();
    return fmaxf(v, off);
}
DI void p9_chunk_prep(Frame& F) {
    const bf16* QKPRE = (const bf16*)(F.ws + WS_PA1); const float* GATES = (const float*)(F.ws + WS_GATES);
    bf16* QG = (bf16*)(F.ws + WS_QG); bf16* KT = (bf16*)(F.ws + WS_KT); bf16* SS = (bf16*)(F.ws + WS_SS);
    float* EXPM = (float*)(F.ws + WS_EXPM); float* DEC = (float*)(F.ws + WS_DEC);
    LAS float* Fa = (LAS float*)F.lds;
    LAS float* Aa = Fa + 4096;
    LAS float* Ga = Aa + 4096;
    LAS bf16* qs = (LAS bf16*)(F.lds + 49152);
    LAS bf16* ks = qs + 64 * QS_STRIDE;
    LAS float* wtot = (LAS float*)(F.lds + AUX_OFF);
    const int tid = F.tid, lane = F.lane, wave = F.wave, fr = lane & 15, fq = lane >> 4;
    for (int grp = blockIdx.x; grp < 256; grp += F.G) {
        const int bh = grp >> 4, b = bh >> 2, h = bh & 3;
        const float ib = F.b_i_bias[h], fb = F.b_f_bias[h];
        __syncthreads();
        {
            float lf[8], run = 0.f;
#pragma unroll
            for (int e = 0; e < 8; ++e) { const float xg = GATES[(size_t)(b * T + 8 * tid + e) * 8 + 4 + h] + fb;
                const float ls = fminf(xg, 0.f) - log1pf(__expf(-fabsf(xg))); run += ls; lf[e] = run; }
            const float incl = block_scan_add(run, wtot, lane, wave); const float off = incl - run;
            float av[8], mx = -INFINITY;
#pragma unroll
            for (int e = 0; e < 8; ++e) { const float Fv = lf[e] + off; Fa[8 * tid + e] = Fv;
                const float a = GATES[(size_t)(b * T + 8 * tid + e) * 8 + h] + ib - Fv; Aa[8 * tid + e] = a; mx = fmaxf(mx, a); av[e] = mx; }
            const float inclm = block_scan_max(mx, wtot, lane, wave);
            LAS float* tmp = (LAS float*)(F.lds + 49152);
            tmp[tid] = inclm;
            __syncthreads();
            const float excl = (tid > 0) ? tmp[tid - 1] : -INFINITY;
#pragma unroll
            for (int e = 0; e < 8; ++e) Ga[8 * tid + e] = fmaxf(0.f, fmaxf(excl, av[e]));
            __syncthreads();
        }
        for (int cq = 0; cq < 4; ++cq) {
            const int c = (grp & 15) * 4 + cq, tb = 64 * c;
            const float Gprev = (c == 0) ? 0.f : Ga[tb - 1], Gend = Ga[tb + 63];
            if (tid == 0) DEC[bh * 64 + c] = __expf(Gprev - Gend);
            if (tid < 64) EXPM[bh * 4096 + tb + tid] = __expf(-(Fa[tb + tid] + Ga[tb + tid]));
            {
                const int p = tid & 255, rh = tid >> 8, isk = (p >= 128) ? 1 : 0, dcol = 2 * (p & 127);
                const int gcol = isk * 1024 + h * 256 + dcol;
                float w0[4], w1[4];
#pragma unroll
                for (int j = 0; j < 4; ++j) { w0[j] = F.b_conv_w[j * 2048 + gcol]; w1[j] = F.b_conv_w[j * 2048 + gcol + 1]; }
                const float cb0 = F.b_conv_b[gcol], cb1 = F.b_conv_b[gcol + 1];
                float u0[3], u1[3];
#pragma unroll
                for (int j = 0; j < 3; ++j) { const int tt = tb + 32 * rh - 3 + j; unsigned raw = 0u; if (tt >= 0) raw = *(const unsigned*)(QKPRE + (size_t)(b * T + tt) * 2048 + gcol); u0[j] = bflo(raw); u1[j] = bfhi(raw); }
                unsigned kacc0[4], kacc1[4];
                for (int r8 = 0; r8 < 4; ++r8) {
#pragma unroll
                for (int sl = 0; sl < 8; ++sl) {
                    const int rr = 8 * r8 + sl, tl = 32 * rh + rr, tt = tb + tl;
                    const unsigned raw = *(const unsigned*)(QKPRE + (size_t)(b * T + tt) * 2048 + gcol);
                    const float c0 = bflo(raw), c1 = bfhi(raw);
                    const float y0 = siluf(w0[0] * u0[0] + w0[1] * u0[1] + w0[2] * u0[2] + w0[3] * c0 + cb0);
                    const float y1 = siluf(w1[0] * u1[0] + w1[1] * u1[1] + w1[2] * u1[2] + w1[3] * c1 + cb1);
                    u0[0] = u0[1]; u0[1] = u0[2]; u0[2] = c0; u1[0] = u1[1]; u1[1] = u1[2]; u1[2] = c1;
                    if (!isk) {
                        const float q0 = y0 * 0.0625f, q1 = y1 * 0.0625f;
                        *(LAS unsigned*)(qs + tl * QS_STRIDE + dcol) = pk2(q0, q1);
                        const float gi = __expf(Gprev - Ga[tt]);
                        *(unsigned*)(QG + ((size_t)(bh * 64 + c) * 64 + tl) * 256 + dcol) = pk2(q0 * gi, q1 * gi);
                    } else {
                        *(LAS unsigned*)(ks + tl * QS_STRIDE + dcol) = pk2(y0, y1);
                        const float wk = __expf(Aa[tt] - Gend);
                        const unsigned e0 = f2bf(y0 * wk), e1 = f2bf(y1 * wk);
                        if ((sl & 1) == 0) { kacc0[sl >> 1] = e0; kacc1[sl >> 1] = e1; } else { kacc0[sl >> 1] |= e0 << 16; kacc1[sl >> 1] |= e1 << 16; }
                        if (sl == 7) {
                            bf16* kt0 = KT + ((size_t)(bh * 64 + c) * 256 + dcol) * 64 + (tl - 7);
                            *(u32x4*)kt0 = (u32x4){kacc0[0], kacc0[1], kacc0[2], kacc0[3]};
                            *(u32x4*)(kt0 + 64) = (u32x4){kacc1[0], kacc1[1], kacc1[2], kacc1[3]};
                        }
                    }
                }
                }
            }
            __syncthreads();
            {
                const int st = wave >> 1;
#pragma unroll
                for (int tq = 0; tq < 2; ++tq) {
                    const int tt = 2 * (wave & 1) + tq;
                    f32x4 acc = (f32x4){0.f, 0.f, 0.f, 0.f};
                    if (st <= tt) {
#pragma unroll
                        for (int kk = 0; kk < 8; ++kk) {
                            const bf16x8 a = *(const LAS bf16x8*)(ks + (16 * st + fr) * QS_STRIDE + 32 * kk + 8 * fq);
                            const bf16x8 bb = *(const LAS bf16x8*)(qs + (16 * tt + fr) * QS_STRIDE + 32 * kk + 8 * fq);
                            acc = __builtin_amdgcn_mfma_f32_16x16x32_bf16(a, bb, acc, 0, 0, 0);
                        }
                    }
                    const int tl = 16 * tt + fr; const float Gt = Ga[tb + tl];
                    float o[4];
#pragma unroll
                    for (int rg = 0; rg < 4; ++rg) { const int sl = 16 * st + 4 * fq + rg; o[rg] = (sl <= tl) ? acc[rg] * __expf(Aa[tb + sl] - Gt) : 0.f; }
                    u32x2 w; w.x = pk2(o[0], o[1]); w.y = pk2(o[2], o[3]);
                    *(u32x2*)(SS + ((size_t)(bh * 64 + c) * 64 + tl) * 64 + 16 * st + 4 * fq) = w;
                }
            }
            __syncthreads();
        }
    }
}

constexpr int CT_STRIDE = 272;
constexpr int VT_STRIDE = 48;
DI void p10_scan(Frame& F) {
    const bf16* QG = (const bf16*)(F.ws + WS_QG); const bf16* KT = (const bf16*)(F.ws + WS_KT); const bf16* SS = (const bf16*)(F.ws + WS_SS);
    const bf16* V = (const bf16*)(F.ws + WS_V); const float* EXPM = (const float*)(F.ws + WS_EXPM); const float* DEC = (const float*)(F.ws + WS_DEC);
    bf16* HH = (bf16*)(F.ws + WS_PA1); float* SSQ = (float*)(F.ws + WS_SSQ);
    LAS bf16* CT = (LAS bf16*)F.lds;
    LAS bf16* VT = (LAS bf16*)(F.lds + 2 * 48 * CT_STRIDE * 2);
    const int tid = F.tid, lane = F.lane, wave = F.wave, fr = lane & 15, fq = lane >> 4;
    const int mt = wave >> 1, vt = wave & 1;
    const int q4 = (lane & 15) >> 2, p4 = lane & 3;
    for (int unit = blockIdx.x; unit < 256; unit += F.G) {
        const int bh = unit >> 4, jsl = unit & 15, b = bh >> 2, h = bh & 3;
        __syncthreads();
        for (int i = tid; i < 2 * 48 * CT_STRIDE / 2; i += 512) ((LAS unsigned*)CT)[i] = 0u;
        for (int i = tid; i < 2 * 64; i += 512) {
#pragma unroll
            for (int q = 0; q < 8; ++q) ((LAS unsigned*)(VT + i * VT_STRIDE + 32))[q] = (q == 0) ? 0x00003F80u : 0u;
        }
        f32x4 cst[2][3];
#pragma unroll
        for (int dt = 0; dt < 2; ++dt)
#pragma unroll
            for (int v3 = 0; v3 < 3; ++v3) cst[dt][v3] = (f32x4){0.f, 0.f, 0.f, 0.f};
        bf16x8 qf[8], nqf[8]; u32x2 sfl[2], sfh[2], nsfl[2], nsfh[2]; u32x2 kfl[2][2], kfh[2][2], nkfl[2][2], nkfh[2][2]; u32x2 nv; f32x4 e4, ne4; float dec, ndec;
        const int vrow = tid >> 3, vpc = tid & 7;
#define P10_LOAD(cc) do { const size_t cb_ = (size_t)(bh * 64 + (cc)); \
            _Pragma("unroll") for (int kk = 0; kk < 8; ++kk) nqf[kk] = *(const bf16x8*)(QG + (cb_ * 64 + 16 * mt + fr) * 256 + 32 * kk + 8 * fq); \
            _Pragma("unroll") for (int s2 = 0; s2 < 2; ++s2) { const bf16* sp = SS + (cb_ * 64 + 16 * mt + fr) * 64 + 32 * s2 + 4 * fq; nsfl[s2] = *(const u32x2*)sp; nsfh[s2] = *(const u32x2*)(sp + 16); } \
            _Pragma("unroll") for (int dt = 0; dt < 2; ++dt) _Pragma("unroll") for (int s2 = 0; s2 < 2; ++s2) { const bf16* kp = KT + (cb_ * 256 + 16 * (2 * wave + dt) + fr) * 64 + 32 * s2 + 4 * fq; nkfl[dt][s2] = *(const u32x2*)kp; nkfh[dt][s2] = *(const u32x2*)(kp + 16); } \
            nv = *(const u32x2*)(V + (size_t)(b * T + 64 * (cc) + vrow) * 2048 + h * 512 + 32 * jsl + 4 * vpc); \
            ne4 = *(const f32x4*)(EXPM + bh * 4096 + 64 * (cc) + 16 * mt + 4 * fq); ndec = DEC[bh * 64 + (cc)]; } while (0)
#define P10_ROTATE() do { _Pragma("unroll") for (int kk = 0; kk < 8; ++kk) qf[kk] = nqf[kk]; \
            _Pragma("unroll") for (int s2 = 0; s2 < 2; ++s2) { sfl[s2] = nsfl[s2]; sfh[s2] = nsfh[s2]; } \
            _Pragma("unroll") for (int dt = 0; dt < 2; ++dt) _Pragma("unroll") for (int s2 = 0; s2 < 2; ++s2) { kfl[dt][s2] = nkfl[dt][s2]; kfh[dt][s2] = nkfh[dt][s2]; } \
            e4 = ne4; dec = ndec; } while (0)
        P10_LOAD(0);
        *(LAS u32x2*)(VT + vrow * VT_STRIDE + 4 * vpc) = nv;
        P10_ROTATE();
        for (int c = 0; c < 64; ++c) {
            const int cur = c & 1;
            LAS bf16* CTc = CT + cur * 48 * CT_STRIDE; LAS bf16* CTn = CT + (cur ^ 1) * 48 * CT_STRIDE;
            LAS bf16* VTc = VT + cur * 64 * VT_STRIDE; LAS bf16* VTn = VT + (cur ^ 1) * 64 * VT_STRIDE;
            LDS_WAIT();
            __syncthreads();
            if (c + 1 < 64) P10_LOAD(c + 1);
            f32x4 o = (f32x4){0.f, 0.f, 0.f, 0.f}, dn = (f32x4){0.f, 0.f, 0.f, 0.f};
#pragma unroll
            for (int kk = 0; kk < 8; ++kk) {
                const bf16x8 bc = *(const LAS bf16x8*)(CTc + (16 * vt + fr) * CT_STRIDE + 32 * kk + 8 * fq);
                const bf16x8 bd = *(const LAS bf16x8*)(CTc + (32 + fr) * CT_STRIDE + 32 * kk + 8 * fq);
                o = __builtin_amdgcn_mfma_f32_16x16x32_bf16(qf[kk], bc, o, 0, 0, 0);
                dn = __builtin_amdgcn_mfma_f32_16x16x32_bf16(qf[kk], bd, dn, 0, 0, 0);
            }
            bf16x8 bv[3][2];
#pragma unroll
            for (int v3 = 0; v3 < 3; ++v3)
#pragma unroll
                for (int s2 = 0; s2 < 2; ++s2) {
                    const s16x4 lo = __builtin_amdgcn_ds_read_tr16_b64_v4i16((LAS s16x4*)(VTc + (32 * s2 + 4 * fq + q4) * VT_STRIDE + 16 * v3 + 4 * p4));
                    const s16x4 hi = __builtin_amdgcn_ds_read_tr16_b64_v4i16((LAS s16x4*)(VTc + (32 * s2 + 16 + 4 * fq + q4) * VT_STRIDE + 16 * v3 + 4 * p4));
                    bv[v3][s2] = (bf16x8){lo[0], lo[1], lo[2], lo[3], hi[0], hi[1], hi[2], hi[3]};
                }
#pragma unroll
            for (int s2 = 0; s2 < 2; ++s2) {
                const bf16x8 sa = __builtin_bit_cast(bf16x8, (u32x4){sfl[s2].x, sfl[s2].y, sfh[s2].x, sfh[s2].y});
                const s16x4 lo = __builtin_amdgcn_ds_read_tr16_b64_v4i16((LAS s16x4*)(VTc + (32 * s2 + 4 * fq + q4) * VT_STRIDE + 16 * vt + 4 * p4));
                const s16x4 hi = __builtin_amdgcn_ds_read_tr16_b64_v4i16((LAS s16x4*)(VTc + (32 * s2 + 16 + 4 * fq + q4) * VT_STRIDE + 16 * vt + 4 * p4));
                const bf16x8 bo = (bf16x8){lo[0], lo[1], lo[2], lo[3], hi[0], hi[1], hi[2], hi[3]};
                o = __builtin_amdgcn_mfma_f32_16x16x32_bf16(sa, bo, o, 0, 0, 0);
                dn = __builtin_amdgcn_mfma_f32_16x16x32_bf16(sa, bv[2][s2], dn, 0, 0, 0);
            }
#pragma unroll
            for (int dt = 0; dt < 2; ++dt)
#pragma unroll
                for (int v3 = 0; v3 < 3; ++v3) {
                    f32x4 a = cst[dt][v3] * dec;
#pragma unroll
                    for (int s2 = 0; s2 < 2; ++s2) {
                        const bf16x8 ka = __builtin_bit_cast(bf16x8, (u32x4){kfl[dt][s2].x, kfl[dt][s2].y, kfh[dt][s2].x, kfh[dt][s2].y});
                        a = __builtin_amdgcn_mfma_f32_16x16x32_bf16(ka, bv[v3][s2], a, 0, 0, 0);
                    }
                    cst[dt][v3] = a;
                    u32x2 w; w.x = pk2(a[0], a[1]); w.y = pk2(a[2], a[3]);
                    *(LAS u32x2*)(CTn + (16 * v3 + fr) * CT_STRIDE + 16 * (2 * wave + dt) + 4 * fq) = w;
                }
            {
                const size_t tokb = (size_t)(b * T + 64 * c + 16 * mt + 4 * fq);
                float sq[4];
#pragma unroll
                for (int rg = 0; rg < 4; ++rg) {
                    const float den = __shfl(dn[rg], lane & 48);
                    const float hv = o[rg] / fmaxf(fabsf(den), e4[rg]);
                    HH[(tokb + rg) * 2048 + h * 512 + 32 * jsl + 16 * vt + fr] = (bf16)f2bf(hv);
                    float s = hv * hv; s += __shfl_xor(s, 1); s += __shfl_xor(s, 2); s += __shfl_xor(s, 4); s += __shfl_xor(s, 8); sq[rg] = s;
                }
                if (fr == 0) {
#pragma unroll
                    for (int rg = 0; rg < 4; ++rg) SSQ[((tokb + rg) * 4 + h) * 32 + 2 * jsl + vt] = sq[rg];
                }
            }
            if (c + 1 < 64) { *(LAS u32x2*)(VTn + vrow * VT_STRIDE + 4 * vpc) = nv; P10_ROTATE(); }
        }
#undef P10_ROTATE
#undef P10_LOAD
    }
}

struct Args { const float* in[17]; float* out; unsigned char* ws; int ph_lo, ph_hi; };
constexpr int N_PHASES = 13;

__global__ void __launch_bounds__(512, 2) mk_fwd(Args args) {
    extern __shared__ __attribute__((aligned(16))) unsigned char lds[];
    Frame F;
    F.lds = (LAS unsigned char*)lds;
    F.tid = threadIdx.x; F.lane = F.tid & 63; F.wave = __builtin_amdgcn_readfirstlane(F.tid >> 6); F.G = gridDim.x;
    F.x = args.in[0]; F.a_w_in = args.in[1]; F.a_kv_g = args.in[2]; F.a_w_uk = args.in[3]; F.a_w_uv = args.in[4]; F.a_w_out = args.in[5]; F.a_ln_g = args.in[6]; F.a_ln_b = args.in[7];
    F.b_w_in = args.in[8]; F.b_i_bias = args.in[9]; F.b_f_bias = args.in[10]; F.b_conv_w = args.in[11]; F.b_conv_b = args.in[12]; F.b_hn_g = args.in[13]; F.b_w_out = args.in[14];
    F.b_ln_g = args.in[15]; F.b_ln_b = args.in[16]; F.out = args.out; F.ws = args.ws;
    volatile LAS unsigned* MISC = (volatile LAS unsigned*)(F.lds + MISC_OFF);
    if (F.tid < 64) MISC[F.tid] = 0u;
    __syncthreads();
    const int lo = args.ph_lo, hi = args.ph_hi;
    XcdBarrier bar; bar.bar = (unsigned*)(F.ws + WS_CTL) + CW_BAR; bar.x = 0; bar.st = nullptr;
    if (hi - lo > 1) bar = xcd_barrier_post((unsigned*)(F.ws + WS_CTL) + CW_BAR, MISC + 8);
#ifndef PHMASK
#define PHMASK 0xFFFF
#endif
#define IN(k) (((PHMASK >> (k)) & 1) && lo <= (k) && (k) < hi)
#define SEAM(k) do { if (IN(k) && IN((k) + 1)) xcd_barrier(bar); } while (0)
    typedef pg8::bf16_t pb;
    unsigned char* ws = F.ws;
    const int c = (int)blockIdx.x;

    if (IN(0)) { p0_prologue(F); } SEAM(0);
    if (IN(1)) {
        pg8::Gemm g{(const pb*)(ws + WS_XB), (const pb*)(ws + WS_WA), M, 3072, 1024, 1024, 1024, 0}; pg8::StaticOrder S; S.init(M, 3072, F.G, c);
        pg8::EpiB2 E{(pb*)(ws + WS_PA1), 2048, (pb*)(ws + WS_ZA), 1024, 8, 1.f};
        pg8::gemm_phase(F.lds, g, S, E);
    } SEAM(1);
    if (IN(2)) {
#if !defined(X_NO_CKV)
        p2_ckv(F);
        __syncthreads();
#endif
#if !defined(X_NO_QLAT)
        pg8::Gemm g{(const pb*)(ws + WS_PA1), (const pb*)(ws + WS_WUK), M, 2048, 128, 2048, 128, 128}; pg8::StaticOrder S; S.init(M, 2048, F.G, c);
        pg8::EpiB2 E{(pb*)(ws + WS_QLAT), 2048, (pb*)(ws + WS_QLAT), 2048, 1 << 30, 0.08838834764831845f};
        pg8::gemm_phase(F.lds, g, S, E);
        __syncthreads();
#endif
#if !defined(X_NO_TOPK)
        p3_index_topk(F);
#endif
    } SEAM(2);
    if (IN(3)) { p4_attention(F); } SEAM(3);
    if (IN(4)) {
        pg8::Gemm g{(const pb*)(ws + WS_PA1), (const pb*)(ws + WS_WUVB), M, 1024, 512, 2048, 512, 512}; pg8::StaticOrder S; S.init(M, 1024, F.G, c);
        pg8::EpiSilu E{(pb*)(ws + WS_XB), 1024, (const pb*)(ws + WS_ZA), 1024};
        pg8::gemm_phase(F.lds, g, S, E);
    } SEAM(4);
    if (IN(5)) {
        pg8::Gemm g{(const pb*)(ws + WS_XB), (const pb*)(ws + WS_WAO), M, 1024, 1024, 1024, 1024, 0}; pg8::StaticOrder S; S.init(M, 1024, F.G, c);
        pg8::EpiRes E{F.x, F.out, 1024, ALPHA};
        pg8::gemm_phase(F.lds, g, S, E);
    } SEAM(5);
    if (IN(6)) { p_ln_rows<true>(F, F.a_ln_g, F.a_ln_b); } SEAM(6);
    if (IN(7)) {
        pg8::Gemm g{(const pb*)(ws + WS_XB), (const pb*)(ws + WS_WBI), M, 4096, 1024, 1024, 1024, 0}; pg8::StaticOrder S; S.init(M, 4096, F.G, c);
        pg8::EpiB2 E{(pb*)(ws + WS_PA1), 2048, (pb*)(ws + WS_V), 2048, 8, 1.f};
        pg8::gemm_phase(F.lds, g, S, E);
    } SEAM(7);
    if (IN(8)) { p9_chunk_prep(F); } SEAM(8);
    if (IN(9)) { p10_scan(F); } SEAM(9);
    if (IN(10)) {
        pg8::Gemm g{(const pb*)(ws + WS_XB), (const pb*)(ws + WS_WBI) + (size_t)4096 * 1024, M, 4096, 1024, 1024, 1024, 0}; pg8::StaticOrder S; S.init(M, 4096, F.G, c);
        pg8::EpiGate E{(pb*)(ws + WS_PA1), (const float*)(ws + WS_SSQ), F.b_hn_g};
        pg8::gemm_phase(F.lds, g, S, E);
    } SEAM(10);
    if (IN(11)) {
        pg8::Gemm g{(const pb*)(ws + WS_PA1), (const pb*)(ws + WS_WBO), M, 1024, 2048, 2048, 2048, 0}; pg8::StaticOrder S; S.init(M, 1024, F.G, c);
        pg8::EpiRes E{F.out, F.out, 1024, ALPHA};
        pg8::gemm_phase(F.lds, g, S, E);
    } SEAM(11);
    if (IN(12)) { p_ln_rows<false>(F, F.b_ln_g, F.b_ln_b); }
#undef IN
#undef SEAM
}


#ifndef MK_CHECK
#define MK_CHECK 0
#endif
#if MK_CHECK
constexpr size_t WS_CHK = 32768;
constexpr size_t WS_SAVE_HH = 256 * 1024;
constexpr size_t WS_SAVE_X1 = 512 * 1024;
struct CA { const float* in[17]; float* out; unsigned char* ws; int id; };
DI unsigned hsh(unsigned x) { x ^= x >> 16; x *= 0x7feb352du; x ^= x >> 15; x *= 0x846ca68bu; x ^= x >> 16; return x; }
DI void chk_acc(unsigned char* ws, int id, float fast, float ref) {
    float d = (fast - ref); d = d * d; float r = ref * ref;
    if (!(d == d) || !(fast - fast == 0.f)) d = 1e30f;
    d = wave_sum(d); r = wave_sum(r);
    if ((threadIdx.x & 63) == 0) { atomicAdd((float*)(ws + WS_CHK) + 2 * id, d); atomicAdd((float*)(ws + WS_CHK) + 2 * id + 1, r); }
}
DI int samp_tok(int i) { return (int)(hsh(0x1234567u + i) % (unsigned)M); }
__global__ void __launch_bounds__(256) chk1(CA a) {
    const int i = blockIdx.x * 256 + threadIdx.x; const int tok = samp_tok(i), cs = (int)(hsh(i * 3 + 1) % 2888u);
    const float* x = a.in[0] + (size_t)tok * D; const float* w = a.in[1] + cs; float r = 0.f;
    for (int k = 0; k < D; ++k) r += x[k] * w[(size_t)k * A_IN];
    const bf16* PA1 = (const bf16*)(a.ws + WS_PA1); const bf16* ZA = (const bf16*)(a.ws + WS_ZA);
    const float f = cs < 1864 ? bf2f(PA1[(size_t)tok * 2048 + cs]) : bf2f(ZA[(size_t)tok * 1024 + cs - 1864]);
    chk_acc(a.ws, 1, f, r);
}
__global__ void __launch_bounds__(256) chk2(CA a) {
    const int i = blockIdx.x * 256 + threadIdx.x; const int tok = samp_tok(i);
    const bf16* PA1 = (const bf16*)(a.ws + WS_PA1);
    { const int c = (int)(hsh(i * 5 + 2) % 256u); float ss = 0.f; for (int k = 0; k < 256; ++k) { const float v = bf2f(PA1[(size_t)tok * 2048 + 1024 + k]); ss += v * v; }
      const float r = bf2f(PA1[(size_t)tok * 2048 + 1024 + c]) / sqrtf(ss / 256.f + LN_EPS) * a.in[2][c];
      chk_acc(a.ws, 2, bf2f(((const bf16*)(a.ws + WS_CKV))[(size_t)tok * 256 + c]), r); }
    { const int h = (int)(hsh(i * 7 + 3) % 8u), c = (int)(hsh(i * 11 + 4) % 256u); float r = 0.f;
      for (int d = 0; d < 128; ++d) r += bf2f(PA1[(size_t)tok * 2048 + h * 128 + d]) * a.in[3][((size_t)h * 128 + d) * 256 + c];
      r *= 0.08838834764831845f;
      chk_acc(a.ws, 3, bf2f(((const bf16*)(a.ws + WS_QLAT))[(size_t)tok * 2048 + h * 256 + c]), r); }
}
__global__ void __launch_bounds__(256) chk4(CA a) {
    __shared__ float sc[4096]; __shared__ float qi[512]; __shared__ float wi[8];
    const int tok = (blockIdx.x < 8) ? (int)(blockIdx.x * 37 + (blockIdx.x & 3) * T) : samp_tok(1000 + blockIdx.x); const int b = tok / T, t = tok % T, tid = threadIdx.x;
    const bf16* PA1 = (const bf16*)(a.ws + WS_PA1);
    for (int k = tid; k < 512; k += 256) qi[k] = bf2f(PA1[(size_t)tok * 2048 + 1280 + k]);
    if (tid < 8) wi[tid] = bf2f(PA1[(size_t)tok * 2048 + 1856 + tid]);
    __syncthreads();
    for (int s = tid; s <= t; s += 256) { float tot = 0.f;
        for (int h = 0; h < 8; ++h) { float d = 0.f; for (int k = 0; k < 64; ++k) d += qi[h * 64 + k] * bf2f(PA1[(size_t)(b * T + s) * 2048 + 1792 + k]); tot += wi[h] * fmaxf(d, 0.f); }
        sc[s] = tot; }
    __syncthreads();
    const int idx = ((const short*)(a.ws + WS_SEL))[(size_t)tok * 256 + tid]; const int nvalid = (t + 1 < 256) ? t + 1 : 256;
    float bad = 0.f;
    if (idx < 0) { bad = 1.f; }
    else if (idx > t) bad = 1.f;
    else { int rank = 0; for (int s = 0; s <= t; ++s) rank += (sc[s] > sc[idx]) ? 1 : 0; if (rank >= 258) bad = 1.f; }
    __shared__ int nv; if (tid == 0) nv = 0; __syncthreads(); if (idx >= 0) atomicAdd(&nv, 1); __syncthreads();
    if (idx < 0 && nv == nvalid) bad = 0.f;
    if (idx >= 0) {
        for (int e = 0; e < tid; ++e) if (((const short*)(a.ws + WS_SEL))[(size_t)tok * 256 + e] == idx) bad = 1.f; }
    chk_acc(a.ws, 4, bad, 0.f); if (tid == 0) atomicAdd((float*)(a.ws + WS_CHK) + 2 * 4 + 1, 256.f);
}
__global__ void __launch_bounds__(256) chk5(CA a) {
    __shared__ float lg[8][256]; __shared__ float ql[2048]; __shared__ int kid[256]; __shared__ float inv[8];
    const int tok = (blockIdx.x < 8) ? (int)(blockIdx.x * 37 + (blockIdx.x & 3) * T) : samp_tok(2000 + blockIdx.x); const int b = tok / T, t = tok % T, tid = threadIdx.x;
    const bf16* CKV = (const bf16*)(a.ws + WS_CKV); const bf16* QLAT = (const bf16*)(a.ws + WS_QLAT);
    for (int k = tid; k < 2048; k += 256) ql[k] = bf2f(QLAT[(size_t)tok * 2048 + k]);
    kid[tid] = ((const short*)(a.ws + WS_SEL))[(size_t)tok * 256 + tid];
    __syncthreads();
    const int kd = kid[tid];
    for (int h = 0; h < 8; ++h) { float d = -INFINITY;
        if (kd >= 0) { d = 0.f; for (int c = 0; c < 256; ++c) d += ql[h * 256 + c] * bf2f(CKV[(size_t)(b * T + kd) * 256 + c]); d -= exp2f(-(float)(h + 1)) * (float)(t - kd); }
        lg[h][tid] = d; }
    __syncthreads();
    if (tid < 8) { float mx = -INFINITY; for (int k = 0; k < 256; ++k) mx = fmaxf(mx, lg[tid][k]); float sm = 0.f; for (int k = 0; k < 256; ++k) { const float p = expf(lg[tid][k] - mx); lg[tid][k] = p; sm += p; } inv[tid] = 1.f / sm; }
    __syncthreads();
    const bf16* OLAT = (const bf16*)(a.ws + WS_PA1);
    for (int h = 0; h < 8; ++h) { float o = 0.f; for (int k = 0; k < 256; ++k) if (kid[k] >= 0) o += lg[h][k] * bf2f(CKV[(size_t)(b * T + kid[k]) * 256 + tid]);
        chk_acc(a.ws, 5, bf2f(OLAT[(size_t)tok * 2048 + h * 256 + tid]), o * inv[h]); }
}
__global__ void __launch_bounds__(256) chk6(CA a) {
    const int i = blockIdx.x * 256 + threadIdx.x; const int tok = samp_tok(3000 + i), n = (int)(hsh(i * 13 + 5) % 1024u), h = n >> 7, dd = n & 127;
    const bf16* OLAT = (const bf16*)(a.ws + WS_PA1); float o = 0.f;
    for (int c = 0; c < 256; ++c) o += bf2f(OLAT[(size_t)tok * 2048 + h * 256 + c]) * a.in[4][((size_t)h * 256 + c) * 128 + dd];
    const float z = bf2f(((const bf16*)(a.ws + WS_ZA))[(size_t)tok * 1024 + n]);
    chk_acc(a.ws, 6, bf2f(((const bf16*)(a.ws + WS_XB))[(size_t)tok * 1024 + n]), o * (z / (1.f + expf(-z))));
}
__global__ void __launch_bounds__(256) chk7(CA a) {
    const int i = blockIdx.x * 256 + threadIdx.x; const int tok = samp_tok(4000 + i), n = (int)(hsh(i * 17 + 6) % 1024u);
    const bf16* GZ = (const bf16*)(a.ws + WS_XB); float r = 0.f;
    for (int k = 0; k < 1024; ++k) r += bf2f(GZ[(size_t)tok * 1024 + k]) * a.in[5][(size_t)k * 1024 + n];
    r += ALPHA * a.in[0][(size_t)tok * D + n];
    chk_acc(a.ws, 7, a.out[(size_t)tok * D + n], r);
}
__global__ void __launch_bounds__(256) chk8(CA a) {
    __shared__ float u[1024]; __shared__ float red[256]; __shared__ float x1s[1024];
    const int tok = samp_tok(5000 + blockIdx.x), tid = threadIdx.x;
    const bf16* GZ = (const bf16*)(a.ws + WS_XB);
    (void)GZ;
    for (int k = tid; k < 1024; k += 256) x1s[k] = a.out[(size_t)tok * D + k];
    __syncthreads();
    float s = 0.f; for (int k = tid; k < 1024; k += 256) s += x1s[k]; red[tid] = s; __syncthreads();
    for (int o = 128; o > 0; o >>= 1) { if (tid < o) red[tid] += red[tid + o]; __syncthreads(); }
    (void)u;
    for (int k = tid; k < 1024; k += 256) chk_acc(a.ws, 8, bf2f(((const bf16*)(a.ws + WS_XB))[(size_t)tok * 1024 + k]), x1s[k]);
    if (tid < 64) { const int j = tid & 7; float g = 0.f; for (int k = 0; k < 1024; ++k) g += x1s[k] * a.in[8][(size_t)k * B_IN + 4096 + j];
        chk_acc(a.ws, 9, ((const float*)(a.ws + WS_GATES))[(size_t)tok * 8 + j], g); }
}
__global__ void __launch_bounds__(256) chk10_save(CA a) { const int tok = samp_tok(6000 + blockIdx.x); for (int k = threadIdx.x; k < 1024; k += 256) ((float*)(a.ws + WS_SAVE_X1))[blockIdx.x * 1024 + k] = a.out[(size_t)tok * D + k]; }
__global__ void __launch_bounds__(256) chk10(CA a) {
    __shared__ float red[256]; const int tok = samp_tok(6000 + blockIdx.x), tid = threadIdx.x; const float* u = (const float*)(a.ws + WS_SAVE_X1) + blockIdx.x * 1024;
    const float* gam = a.id == 10 ? a.in[6] : a.in[15]; const float* bet = a.id == 10 ? a.in[7] : a.in[16];
    float s = 0.f; for (int k = tid; k < 1024; k += 256) s += u[k]; red[tid] = s; __syncthreads();
    for (int o = 128; o > 0; o >>= 1) { if (tid < o) red[tid] += red[tid + o]; __syncthreads(); } const float mean = red[0] / 1024.f; __syncthreads();
    s = 0.f; for (int k = tid; k < 1024; k += 256) s += (u[k] - mean) * (u[k] - mean); red[tid] = s; __syncthreads();
    for (int o = 128; o > 0; o >>= 1) { if (tid < o) red[tid] += red[tid + o]; __syncthreads(); } const float rstd = 1.f / sqrtf(red[0] / 1024.f + LN_EPS);
    for (int k = tid; k < 1024; k += 256) chk_acc(a.ws, a.id, a.out[(size_t)tok * D + k], (u[k] - mean) * rstd * gam[k] + bet[k]);
}
__global__ void __launch_bounds__(256) chk11(CA a) {
    const int i = blockIdx.x * 256 + threadIdx.x; const int tok = samp_tok(7000 + i), col = (int)(hsh(i * 19 + 7) % 4096u); float r = 0.f;
    for (int k = 0; k < 1024; ++k) r += a.out[(size_t)tok * D + k] * a.in[8][(size_t)k * B_IN + col];
    const float f = col < 2048 ? bf2f(((const bf16*)(a.ws + WS_PA1))[(size_t)tok * 2048 + col]) : bf2f(((const bf16*)(a.ws + WS_V))[(size_t)tok * 2048 + col - 2048]);
    chk_acc(a.ws, 11, f, r);
}
DI float conv_ref(const CA& a, int b, int t, int gcol) {
    const bf16* QK = (const bf16*)(a.ws + WS_PA1); float acc = a.in[12][gcol];
    for (int j = 0; j < 4; ++j) { const int tt = t - 3 + j; if (tt >= 0) acc += a.in[11][j * 2048 + gcol] * bf2f(QK[(size_t)(b * T + tt) * 2048 + gcol]); }
    return acc / (1.f + expf(-acc));
}
__global__ void __launch_bounds__(256) chk12(CA a) {
    __shared__ float Fc[64], Ac[64], Gc[64]; __shared__ float Gprev, Gend;
    const int bh = blockIdx.x & 15, c = (int)(hsh(900 + blockIdx.x) % 64u), b = bh >> 2, h = bh & 3, tid = threadIdx.x, tb = 64 * c;
    const float* GATES = (const float*)(a.ws + WS_GATES);
    if (tid == 0) { float Fv = 0.f, mx = -INFINITY, gp = 0.f;
        for (int s = 0; s < tb + 64; ++s) { const float xg = GATES[(size_t)(b * T + s) * 8 + 4 + h] + a.in[10][h]; Fv += fminf(xg, 0.f) - log1pf(expf(-fabsf(xg)));
            const float av = GATES[(size_t)(b * T + s) * 8 + h] + a.in[9][h] - Fv; mx = fmaxf(mx, av); const float G = fmaxf(0.f, mx);
            if (s == tb - 1) gp = G; if (s >= tb) { Fc[s - tb] = Fv; Ac[s - tb] = av; Gc[s - tb] = G; } }
        Gprev = (c == 0) ? 0.f : gp; Gend = Gc[63]; }
    __syncthreads();
    if (tid < 64) chk_acc(a.ws, 12, ((const float*)(a.ws + WS_EXPM))[bh * 4096 + tb + tid], expf(-(Fc[tid] + Gc[tid])));
    if (tid < 64) chk_acc(a.ws, 13, ((const float*)(a.ws + WS_DEC))[bh * 64 + c], expf(Gprev - Gend));
    { const int tl = (int)(hsh(tid * 3 + blockIdx.x * 977) % 64u), d = (int)(hsh(tid * 5 + blockIdx.x * 131 + 1) % 256u);
      const float q = conv_ref(a, b, tb + tl, h * 256 + d) * 0.0625f * expf(Gprev - Gc[tl]);
      chk_acc(a.ws, 14, bf2f(((const bf16*)(a.ws + WS_QG))[((size_t)(bh * 64 + c) * 64 + tl) * 256 + d]), q);
      const float k = conv_ref(a, b, tb + tl, 1024 + h * 256 + d) * expf(Ac[tl] - Gend);
      chk_acc(a.ws, 15, bf2f(((const bf16*)(a.ws + WS_KT))[((size_t)(bh * 64 + c) * 256 + d) * 64 + tl]), k); }
    { const int tl = (int)(hsh(tid * 7 + blockIdx.x * 313 + 2) % 64u), sl = (int)(hsh(tid * 11 + blockIdx.x * 717 + 3) % 64u); float r = 0.f;
      if (sl <= tl) { for (int d = 0; d < 256; ++d) r += conv_ref(a, b, tb + tl, h * 256 + d) * 0.0625f * conv_ref(a, b, tb + sl, 1024 + h * 256 + d); r *= expf(Ac[sl] - Gc[tl]); }
      chk_acc(a.ws, 16, bf2f(((const bf16*)(a.ws + WS_SS))[((size_t)(bh * 64 + c) * 64 + tl) * 64 + sl]), r); }
}
__global__ void __launch_bounds__(256) chk17_pre(CA a) {
    __shared__ float Aa[4096]; __shared__ float cw[4096]; __shared__ float qh[256]; __shared__ float red[256]; __shared__ float Gt, mt;
    const int tok = (blockIdx.x < 4) ? (int)(blockIdx.x * T + 5 + 70 * blockIdx.x) : samp_tok(8000 + blockIdx.x); const int h = blockIdx.x & 3, b = tok / T, t = tok % T, tid = threadIdx.x;
    const float* GATES = (const float*)(a.ws + WS_GATES);
    if (tid == 0) { float Fv = 0.f, mx = -INFINITY;
        for (int s = 0; s <= t; ++s) { const float xg = GATES[(size_t)(b * T + s) * 8 + 4 + h] + a.in[10][h]; Fv += fminf(xg, 0.f) - log1pf(expf(-fabsf(xg)));
            const float av = GATES[(size_t)(b * T + s) * 8 + h] + a.in[9][h] - Fv; Aa[s] = av; mx = fmaxf(mx, av); }
        Gt = fmaxf(0.f, mx); mt = Fv + Gt; }
    qh[tid] = conv_ref(a, b, t, h * 256 + tid) * 0.0625f;
    __syncthreads();
    float dsum = 0.f;
    for (int s = tid; s <= t; s += 256) { float d = 0.f; for (int k = 0; k < 256; ++k) d += qh[k] * conv_ref(a, b, s, 1024 + h * 256 + k); d *= expf(Aa[s] - Gt); cw[s] = d; dsum += d; }
    red[tid] = dsum; __syncthreads();
    for (int o = 128; o > 0; o >>= 1) { if (tid < o) red[tid] += red[tid + o]; __syncthreads(); }
    const float den = fmaxf(fabsf(red[0]), expf(-mt));
    const bf16* V = (const bf16*)(a.ws + WS_V);
    for (int v = tid; v < 512; v += 256) { float num = 0.f; for (int s = 0; s <= t; ++s) num += cw[s] * bf2f(V[(size_t)(b * T + s) * 2048 + h * 512 + v]);
        ((float*)(a.ws + WS_SAVE_HH))[blockIdx.x * 512 + v] = num / den; }
}
__global__ void __launch_bounds__(256) chk17(CA a) {
    const int tok = (blockIdx.x < 4) ? (int)(blockIdx.x * T + 5 + 70 * blockIdx.x) : samp_tok(8000 + blockIdx.x); const int h = blockIdx.x & 3, tid = threadIdx.x;
    const bf16* HH = (const bf16*)(a.ws + WS_PA1); float ss = 0.f;
    for (int v = tid; v < 512; v += 256) { chk_acc(a.ws, 17, bf2f(HH[(size_t)tok * 2048 + h * 512 + v]), ((const float*)(a.ws + WS_SAVE_HH))[blockIdx.x * 512 + v]); }
    if (tid < 64) { float f = 0.f; for (int q = 0; q < 32; ++q) f += ((const float*)(a.ws + WS_SSQ))[((size_t)tok * 4 + h) * 32 + q];
        for (int v = 0; v < 512; ++v) { const float x = bf2f(HH[(size_t)tok * 2048 + h * 512 + v]); ss += x * x; }
        chk_acc(a.ws, 18, f, ss); }
}
__global__ void __launch_bounds__(256) chk19_pre(CA a) { const int tok = samp_tok(9000 + blockIdx.x); for (int k = threadIdx.x; k < 2048; k += 256) ((float*)(a.ws + WS_SAVE_HH))[blockIdx.x * 2048 + k] = bf2f(((const bf16*)(a.ws + WS_PA1))[(size_t)tok * 2048 + k]); }
__global__ void __launch_bounds__(256) chk19(CA a) {
    const int tok = samp_tok(9000 + blockIdx.x), tid = threadIdx.x; const float* hh = (const float*)(a.ws + WS_SAVE_HH) + blockIdx.x * 2048;
    const int col = (int)(hsh(tid * 23 + blockIdx.x * 29 + 8) % 2048u), head = col >> 9;
    float ss = 0.f; for (int v = 0; v < 512; ++v) ss += hh[head * 512 + v] * hh[head * 512 + v];
    float o = 0.f, z = 0.f; for (int k = 0; k < 1024; ++k) { const float xv = a.out[(size_t)tok * D + k]; o += xv * a.in[8][(size_t)k * B_IN + 4104 + col]; z += xv * a.in[8][(size_t)k * B_IN + 6152 + col]; }
    const float r = hh[col] / sqrtf(ss / 512.f + LN_EPS) * a.in[13][col] * (1.f / (1.f + expf(-o))) * (z / (1.f + expf(-z)));
    chk_acc(a.ws, 19, bf2f(((const bf16*)(a.ws + WS_PA1))[(size_t)tok * 2048 + col]), r);
}
__global__ void __launch_bounds__(256) chk20_pre(CA a) { const int tok = samp_tok(9500 + blockIdx.x); for (int k = threadIdx.x; k < 1024; k += 256) ((float*)(a.ws + WS_SAVE_X1))[blockIdx.x * 1024 + k] = a.out[(size_t)tok * D + k]; }
__global__ void __launch_bounds__(256) chk20(CA a) {
    const int tok = samp_tok(9500 + blockIdx.x), tid = threadIdx.x;
    for (int n = tid; n < 1024; n += 256) { float r = ALPHA * ((const float*)(a.ws + WS_SAVE_X1))[blockIdx.x * 1024 + n];
        for (int k = 0; k < 2048; ++k) r += bf2f(((const bf16*)(a.ws + WS_PA1))[(size_t)tok * 2048 + k]) * a.in[14][(size_t)k * 1024 + n];
        chk_acc(a.ws, 20, a.out[(size_t)tok * D + n], r); }
}
__global__ void __launch_bounds__(256) chk_apply(CA a) {
    const float* ch = (const float*)(a.ws + WS_CHK); float scale = 0.f;
    if (MK_CHECK == 1) { for (int id = 1; id <= 21; ++id) { const float e = sqrtf(ch[2 * id] / fmaxf(ch[2 * id + 1], 1e-30f)); const float tol = (id == 4) ? 0.04f : 0.008f; if (ch[2 * id + 1] > 0.f && !(e < tol)) { scale = (float)id; break; } } }
    else { const int id = MK_CHECK - 100; scale = fminf(sqrtf(ch[2 * id] / fmaxf(ch[2 * id + 1], 1e-30f)), 1000.f); }
    for (size_t i = (size_t)blockIdx.x * 256 + threadIdx.x; i < (size_t)M * D; i += (size_t)gridDim.x * 256) a.out[i] *= (1.f + scale);
}
#endif

extern "C" void kernel_launch(void* const* d_in, const int* in_sizes, int n_in, void* d_out, int out_size, void* d_ws, size_t ws_size, hipStream_t stream) {
    static int grid = 0;
    if (grid == 0) {
        if (n_in != 17 || out_size != M * D || ws_size < WS_END) { fprintf(stderr, "kernel_launch: unexpected shapes (n_in %d out %d ws %zu)\n", n_in, out_size, ws_size); grid = -1; return; }
        int dev = 0, cus = 0, per_cu = 0;
        if (hipGetDevice(&dev) != hipSuccess || hipDeviceGetAttribute(&cus, hipDeviceAttributeMultiprocessorCount, dev) != hipSuccess) { grid = -1; return; }
        if (hipFuncSetAttribute((const void*)mk_fwd, hipFuncAttributeMaxDynamicSharedMemorySize, LDS_BYTES) != hipSuccess) { fprintf(stderr, "kernel_launch: hipFuncSetAttribute failed\n"); grid = -1; return; }
        if (hipOccupancyMaxActiveBlocksPerMultiprocessor(&per_cu, (const void*)mk_fwd, 512, LDS_BYTES) != hipSuccess || per_cu < 1) fprintf(stderr, "kernel_launch: occupancy query reports %d\n", per_cu);
        (void)hipGetLastError();
        grid = cus < 256 ? cus : 256;
    }
    if (grid < 0) return;
    (void)hipMemsetAsync((char*)d_ws + WS_CTL, 0, CTL_ZERO_BYTES, stream);
    Args a{};
    for (int i = 0; i < 17; ++i) a.in[i] = (const float*)d_in[i];
    a.out = (float*)d_out; a.ws = (unsigned char*)d_ws;
#if MK_ONE_LAUNCH
    a.ph_lo = 0; a.ph_hi = N_PHASES;
    hipLaunchKernelGGL(mk_fwd, dim3(grid), dim3(512), LDS_BYTES, stream, a);
#else
#if MK_CHECK
    CA ca{}; for (int i = 0; i < 17; ++i) ca.in[i] = (const float*)d_in[i]; ca.out = (float*)d_out; ca.ws = (unsigned char*)d_ws; ca.id = 0;
#endif
    for (int p = 0; p < 13; ++p) {
#if MK_CHECK
        if (p == 6) hipLaunchKernelGGL(chk10_save, dim3(32), dim3(256), 0, stream, ca);
        if (p == 9) hipLaunchKernelGGL(chk17_pre, dim3(32), dim3(256), 0, stream, ca);
        if (p == 10) hipLaunchKernelGGL(chk19_pre, dim3(32), dim3(256), 0, stream, ca);
        if (p == 11) hipLaunchKernelGGL(chk20_pre, dim3(32), dim3(256), 0, stream, ca);
#endif
        a.ph_lo = p; a.ph_hi = p + 1; hipLaunchKernelGGL(mk_fwd, dim3(grid), dim3(512), LDS_BYTES, stream, a);
#if MK_CHECK
        if (p == 1) hipLaunchKernelGGL(chk1, dim3(64), dim3(256), 0, stream, ca);
        if (p == 2) { hipLaunchKernelGGL(chk2, dim3(64), dim3(256), 0, stream, ca); hipLaunchKernelGGL(chk4, dim3(64), dim3(256), 0, stream, ca); }
        if (p == 3) hipLaunchKernelGGL(chk5, dim3(64), dim3(256), 0, stream, ca);
        if (p == 4) hipLaunchKernelGGL(chk6, dim3(64), dim3(256), 0, stream, ca);
        if (p == 5) hipLaunchKernelGGL(chk7, dim3(64), dim3(256), 0, stream, ca);
        if (p == 6) { ca.id = 10; hipLaunchKernelGGL(chk10, dim3(32), dim3(256), 0, stream, ca); hipLaunchKernelGGL(chk8, dim3(32), dim3(256), 0, stream, ca); }
        if (p == 7) hipLaunchKernelGGL(chk11, dim3(64), dim3(256), 0, stream, ca);
        if (p == 8) hipLaunchKernelGGL(chk12, dim3(64), dim3(256), 0, stream, ca);
        if (p == 9) hipLaunchKernelGGL(chk17, dim3(32), dim3(256), 0, stream, ca);
        if (p == 10) hipLaunchKernelGGL(chk19, dim3(32), dim3(256), 0, stream, ca);
        if (p == 11) hipLaunchKernelGGL(chk20, dim3(32), dim3(256), 0, stream, ca);
#endif
    }
#if MK_CHECK
    hipLaunchKernelGGL(chk_apply, dim3(1024), dim3(256), 0, stream, ca);
#endif
#endif
}
```

```cpp
#include <hip/hip_runtime.h>
#include <cstdio>
#include <cstdint>

#ifndef MK_ONE_LAUNCH
#define MK_ONE_LAUNCH 1
#endif

#define GAS __attribute__((address_space(1)))
#define LAS __attribute__((address_space(3)))
#define DI __device__ __forceinline__
typedef unsigned short bf16;
typedef short bf16x8 __attribute__((ext_vector_type(8)));
typedef short s16x4 __attribute__((ext_vector_type(4)));
typedef float f32x4 __attribute__((ext_vector_type(4)));
typedef float f32x2 __attribute__((ext_vector_type(2)));
typedef unsigned u32x4 __attribute__((ext_vector_type(4)));
typedef unsigned u32x2 __attribute__((ext_vector_type(2)));

constexpr int BATCH = 4, T = 4096, D = 1024, M = BATCH * T;
constexpr int A_IN = 2888, B_IN = 8200;
constexpr float LN_EPS = 1e-5f;
constexpr float ALPHA = 1.41421356237f;

constexpr size_t MiB = 1u << 20;
constexpr size_t WS_CTL = 0, CTL_ZERO_BYTES = 64 * 1024;
constexpr size_t WS_WA = 1 * MiB;
constexpr size_t WS_WUK = 7 * MiB;
constexpr size_t WS_WUVB = WS_WUK + MiB / 2;
constexpr size_t WS_WAO = WS_WUVB + MiB;
constexpr size_t WS_WBI = WS_WAO + 2 * MiB;
constexpr size_t WS_WBO = WS_WBI + 16 * MiB;
constexpr size_t WS_WG = WS_WBO + 4 * MiB;
constexpr size_t WS_GATES = WS_WG + 64 * 1024;
constexpr size_t WS_EXPM = WS_GATES + 512 * 1024;
constexpr size_t WS_DEC = WS_EXPM + 256 * 1024;
constexpr size_t WS_XB = 32 * MiB;
constexpr size_t WS_PA1 = 64 * MiB;
constexpr size_t WS_ZA = 128 * MiB;
constexpr size_t WS_CKV = 160 * MiB;
constexpr size_t WS_QLAT = 168 * MiB;
constexpr size_t WS_SEL = 232 * MiB;
constexpr size_t WS_KIDX = 240 * MiB;
constexpr size_t WS_V = 128 * MiB;
constexpr size_t WS_QG = 192 * MiB;
constexpr size_t WS_KT = 224 * MiB;
constexpr size_t WS_SS = 1 * MiB;
constexpr size_t WS_SSQ = WS_WBI;
constexpr size_t WS_END = 256 * MiB;
static_assert(WS_DEC + 4096 <= WS_XB, "ws map");

constexpr int CW_BAR = 1024;

constexpr int RING_BYTES = 131072;
constexpr int AUX_OFF = RING_BYTES;
constexpr int MISC_OFF = AUX_OFF + 8192;
constexpr int LDS_BYTES = 147456;

#ifndef REPMASK
#define REPMASK 0
#endif
#define REP(k) for (int rep_ = 0; rep_ < ((((REPMASK) >> (k)) & 1) ? 2 : 1); ++rep_)
DI float bf2f(unsigned short u) { return __uint_as_float((unsigned)u << 16); }
DI float bflo(unsigned w) { return __uint_as_float(w << 16); }
DI float bfhi(unsigned w) { return __uint_as_float(w & 0xffff0000u); }
DI unsigned f2bf(float f) { unsigned u = __float_as_uint(f); return (u + 0x7fffu + ((u >> 16) & 1u)) >> 16; }
DI unsigned pk2(float lo, float hi) { return f2bf(lo) | (f2bf(hi) << 16); }
DI float wave_sum(float v) {
#pragma unroll
    for (int o = 1; o < 64; o <<= 1) v += __shfl_xor(v, o);
    return v;
}
DI int wave_sum_small(int c) {
    int tot = 0;
#pragma unroll
    for (int b = 0; b < 7; ++b) tot += __popcll(__ballot((c >> b) & 1)) << b;
    return tot;
}
DI unsigned wave_prefix_incl(unsigned x) {
    x += (unsigned)__builtin_amdgcn_update_dpp(0, (int)x, 0x111, 0xf, 0xf, false);
    x += (unsigned)__builtin_amdgcn_update_dpp(0, (int)x, 0x112, 0xf, 0xf, false);
    x += (unsigned)__builtin_amdgcn_update_dpp(0, (int)x, 0x114, 0xf, 0xf, false);
    x += (unsigned)__builtin_amdgcn_update_dpp(0, (int)x, 0x118, 0xf, 0xf, false);
    x += (unsigned)__builtin_amdgcn_update_dpp(0, (int)x, 0x142, 0xa, 0xf, false);
    x += (unsigned)__builtin_amdgcn_update_dpp(0, (int)x, 0x143, 0xc, 0xf, false);
    return x;
}
DI float siluf(float x) { return x / (1.f + __expf(-x)); }
DI float sigmf(float x) { return 1.f / (1.f + __expf(-x)); }
#define LDS_WAIT() asm volatile("s_waitcnt lgkmcnt(0)" ::: "memory")
#define VM_WAIT() asm volatile("s_waitcnt vmcnt(0)" ::: "memory")

namespace pg8 {
typedef unsigned short bf16_t;
constexpr int BM = 256, BK = 64, HALF = 128, HTB = HALF * BK * 2, STAGE_BYTES = 8 * HTB, NXCD = 8, WGM = 8;
__host__ __device__ __forceinline__ int lds_byte(int r, int c) { const int st = (r >> 4) * 2 + (c >> 5), rr = r & 15, cc = c & 31, ob = rr * 64 + cc * 2; return st * 1024 + (ob ^ (((ob >> 9) & 1) << 5)); }
__host__ __device__ __forceinline__ void stage_rc(int b, int& R, int& C) { const int st = b / 1024, sb = b % 1024, swz = sb ^ (((sb >> 9) & 1) << 5); R = (st >> 1) * 16 + swz / 64; C = (st & 1) * 32 + (swz % 64) / 2; }
__host__ __device__ __forceinline__ int perm32(int rho) { const int n = rho >> 4, i = rho & 15; return 8 * (i >> 2) + 4 * n + (i & 3); }
struct Unit { int pm, pn; };
struct Gemm { const bf16_t* A; const bf16_t* Bt; int M, N, K, lda, ldb, a_pn_off; };
struct StaticOrder {
    int nM, nN, nwg, G, c;
    __host__ __device__ void init(int M_, int N_, int G_, int c_) { nM = M_ / BM; nN = N_ / BM; nwg = nM * nN; G = G_; c = c_; }
    __host__ __device__ bool next(int i, Unit& u) const {
        const long L = (long)i * G + c; if (L >= nwg) return false;
        int wgid = (int)L; { const int q = nwg / NXCD, r = nwg % NXCD, xcd = wgid % NXCD, off = wgid / NXCD; wgid = (xcd < r ? xcd * (q + 1) : r * (q + 1) + (xcd - r) * q) + off; }
        const int nig = WGM * nN, gid = wgid / nig, fm = gid * WGM, gsz = (nM - fm) < WGM ? (nM - fm) : WGM;
        u.pm = fm + ((wgid % nig) % gsz); u.pn = (wgid % nig) / gsz; return true;
    }
};
DI unsigned cvt_pk_bf16(float lo, float hi) { unsigned r; asm volatile("v_cvt_pk_bf16_f32 %0, %1, %2" : "=v"(r) : "v"(lo), "v"(hi)); return r; }

template <class Epi>
DI void gemm_phase(LAS unsigned char* lds, const Gemm g, const StaticOrder& S, const Epi& E) {
    const int tid = threadIdx.x, wid = __builtin_amdgcn_readfirstlane(tid >> 6), lane = tid & 63, wr = wid >> 2, wc = wid & 3, fr = lane & 15, fq = lane >> 4;
    const int nt = g.K / BK;
    unsigned voffA[2], voffB[2];
#pragma unroll
    for (int i = 0; i < 2; ++i) { int R, C; stage_rc(tid * 16 + i * 8192, R, C); const int Rb = Epi::PERM ? ((R & ~31) + perm32(R & 31)) : R;
        voffA[i] = (unsigned)(R * g.lda + C) * 2u; voffB[i] = (unsigned)(Rb * g.ldb + C) * 2u; }
    const size_t kstep = (size_t)(BK * 2);
    const size_t hA = (size_t)HALF * g.lda * 2, hB = (size_t)HALF * g.ldb * 2;
    const size_t tA = 2 * hA, tB = 2 * hB;
    const unsigned ldsw = (unsigned)wid * 1024u;
    const int aoff = lds_byte(wr * 64 + fr, fq * 8), boff = lds_byte(wc * 32 + fr, fq * 8);
#define PG8_SA(b, h) (((b) * 2 + (h)) * HTB)
#define PG8_SB(b, h) ((4 + (b) * 2 + (h)) * HTB)
#define PG8_STAGE(bufoff, gbase, voff) do { _Pragma("unroll") for (int _i = 0; _i < 2; ++_i) \
        __builtin_amdgcn_global_load_lds((const unsigned*)((const char*)(gbase) + (voff)[_i]), (LAS unsigned*)(lds + (bufoff) + ldsw + _i * 8192), 16, 0, 0); } while (0)
#define PG8_LDA(dst, b, h) do { _Pragma("unroll") for (int m = 0; m < 4; ++m) _Pragma("unroll") for (int k = 0; k < 2; ++k) dst[m][k] = *(const LAS bf16x8*)(lds + PG8_SA(b, h) + aoff + m * 2048 + k * 1024); } while (0)
#define PG8_LDB(dst, b, h) do { _Pragma("unroll") for (int n = 0; n < 2; ++n) _Pragma("unroll") for (int k = 0; k < 2; ++k) dst[n][k] = *(const LAS bf16x8*)(lds + PG8_SB(b, h) + boff + n * 2048 + k * 1024); } while (0)
#define PG8_MMA(ai, bj, At, Bt) do { __builtin_amdgcn_s_setprio(1); _Pragma("unroll") for (int m = 0; m < 4; ++m) _Pragma("unroll") for (int n = 0; n < 2; ++n) _Pragma("unroll") for (int k = 0; k < 2; ++k) \
        acc[ai][bj][m][n] = __builtin_amdgcn_mfma_f32_16x16x32_bf16(Bt[n][k], At[m][k], acc[ai][bj][m][n], 0, 0, 0); __builtin_amdgcn_s_setprio(0); } while (0)
#define PG8_WAIT_V(n) asm volatile("s_waitcnt vmcnt(" #n ")" ::: "memory")
#define PG8_WAIT_L(n) asm volatile("s_waitcnt lgkmcnt(" #n ")" ::: "memory")
#define PG8_BAR __builtin_amdgcn_s_barrier()
#define PG8_SCHED __builtin_amdgcn_sched_barrier(0)
    Unit cur, nxt; int ui = 0;
    if (!S.next(0, cur)) return;
    f32x4 acc[2][2][4][2];
#pragma unroll
    for (int a = 0; a < 2; ++a)
#pragma unroll
        for (int b = 0; b < 2; ++b)
#pragma unroll
            for (int m = 0; m < 4; ++m)
#pragma unroll
                for (int n = 0; n < 2; ++n) acc[a][b][m][n] = (f32x4){0.f, 0.f, 0.f, 0.f};
    bf16x8 At[4][2], B0[2][2], B1[2][2];
    const char* cA = (const char*)g.A + (size_t)cur.pm * tA + (size_t)cur.pn * g.a_pn_off * 2; const char* cB = (const char*)g.Bt + (size_t)cur.pn * tB;
    PG8_STAGE(PG8_SB(0, 0), cB, voffB); PG8_STAGE(PG8_SB(0, 1), cB + hB, voffB); PG8_STAGE(PG8_SA(0, 0), cA, voffA); PG8_STAGE(PG8_SA(0, 1), cA + hA, voffA);
    if (wr == 1) PG8_BAR;
    PG8_WAIT_V(2); PG8_BAR;
    PG8_STAGE(PG8_SB(1, 0), cB + kstep, voffB); PG8_STAGE(PG8_SA(1, 0), cA + kstep, voffA); PG8_STAGE(PG8_SB(1, 1), cB + hB + kstep, voffB);
    PG8_WAIT_V(6); PG8_BAR;
    for (;;) {
        const bool has_next = S.next(ui + 1, nxt);
        const char* nA = has_next ? (const char*)g.A + (size_t)nxt.pm * tA + (size_t)nxt.pn * g.a_pn_off * 2 : cA; const char* nB = has_next ? (const char*)g.Bt + (size_t)nxt.pn * tB : cB;
        for (int t = 0; t < nt; t += 2) {
            const bool last = (t == nt - 2);
            const char* a1 = cA + (size_t)(t + 1) * kstep;
            const char* a2 = last ? nA : cA + (size_t)(t + 2) * kstep; const char* b2 = last ? nB : cB + (size_t)(t + 2) * kstep;
            const char* a3 = a2 + kstep; const char* b3 = b2 + kstep;
            PG8_LDB(B0, 0, 0); PG8_LDB(B1, 0, 1); PG8_SCHED; PG8_LDA(At, 0, 0); PG8_STAGE(PG8_SA(1, 1), a1 + hA, voffA);
            PG8_WAIT_V(8); PG8_WAIT_L(0); PG8_BAR; PG8_MMA(0, 0, At, B0); PG8_MMA(0, 1, At, B1); PG8_BAR; PG8_SCHED;
            PG8_LDA(At, 0, 1); PG8_STAGE(PG8_SB(0, 0), b2, voffB); PG8_STAGE(PG8_SB(0, 1), b2 + hB, voffB); PG8_STAGE(PG8_SA(0, 0), a2, voffA);
            PG8_WAIT_V(8); PG8_WAIT_L(0); PG8_BAR; PG8_MMA(1, 0, At, B0); PG8_MMA(1, 1, At, B1); PG8_BAR; PG8_SCHED;
            PG8_LDB(B0, 1, 0); PG8_LDB(B1, 1, 1); PG8_SCHED; PG8_LDA(At, 1, 0); PG8_STAGE(PG8_SA(0, 1), a2 + hA, voffA);
            PG8_WAIT_V(8); PG8_WAIT_L(0); PG8_BAR; PG8_MMA(0, 0, At, B0); PG8_MMA(0, 1, At, B1); PG8_BAR; PG8_SCHED;
            PG8_LDA(At, 1, 1); PG8_STAGE(PG8_SB(1, 0), b3, voffB); PG8_STAGE(PG8_SB(1, 1), b3 + hB, voffB); PG8_STAGE(PG8_SA(1, 0), a3, voffA);
            PG8_WAIT_V(8); PG8_WAIT_L(0); PG8_BAR; PG8_MMA(1, 0, At, B0); PG8_MMA(1, 1, At, B1); PG8_BAR; PG8_SCHED;
        }
        if (wr == 0) PG8_BAR;
        E(acc, cur, wr, wc, fr, fq);
        if (!has_next) break;
#pragma unroll
        for (int a = 0; a < 2; ++a)
#pragma unroll
            for (int b = 0; b < 2; ++b)
#pragma unroll
                for (int m = 0; m < 4; ++m)
#pragma unroll
                    for (int n = 0; n < 2; ++n) acc[a][b][m][n] = (f32x4){0.f, 0.f, 0.f, 0.f};
        cur = nxt; cA = nA; cB = nB; ++ui;
        if (wr == 1) PG8_BAR;
    }
    PG8_WAIT_V(0);
    PG8_BAR;
#undef PG8_SA
#undef PG8_SB
#undef PG8_STAGE
#undef PG8_LDA
#undef PG8_LDB
#undef PG8_MMA
#undef PG8_WAIT_V
#undef PG8_WAIT_L
#undef PG8_BAR
#undef PG8_SCHED
}

template <bool HASKX> struct EpiB2T {
    static constexpr bool PERM = true;
    bf16_t* O0; bf16_t* O1; bf16_t* KX; int ld0, ld1, split; float scale;
    DI void operator()(const f32x4 (&acc)[2][2][4][2], const Unit& u, int wr, int wc, int fr, int fq) const {
        const int row0 = u.pm * BM + wr * 64 + fr;
        bf16_t* base; int ld, colt;
        if (u.pn < split) { base = O0; ld = ld0; colt = u.pn * BM; } else { base = O1; ld = ld1; colt = (u.pn - split) * BM; }
        const int col0 = colt + wc * 32 + 8 * fq;
#pragma unroll
        for (int ai = 0; ai < 2; ++ai)
#pragma unroll
            for (int m = 0; m < 4; ++m) { bf16_t* rowp = base + (size_t)(row0 + ai * HALF + m * 16) * ld + col0;
#pragma unroll
                for (int bj = 0; bj < 2; ++bj) { const f32x4 v0 = acc[ai][bj][m][0] * scale, v1 = acc[ai][bj][m][1] * scale;
                    const unsigned w0 = cvt_pk_bf16(v0[0], v0[1]), w1 = cvt_pk_bf16(v0[2], v0[3]), w2 = cvt_pk_bf16(v1[0], v1[1]), w3 = cvt_pk_bf16(v1[2], v1[3]);
                    *(u32x4*)(rowp + bj * HALF) = (u32x4){w0, w1, w2, w3};
                    if constexpr (HASKX) if (bj == 0) { if (u.pn == 7 && wc < 2) *(u32x4*)(KX + (size_t)(row0 + ai * HALF + m * 16) * 64 + wc * 32 + 8 * fq) = (u32x4){w0, w1, w2, w3}; } } }
    }
};
struct EpiSilu {
    static constexpr bool PERM = true;
    bf16_t* O; int ldc; const bf16_t* Z; int ldz;
    DI void operator()(const f32x4 (&acc)[2][2][4][2], const Unit& u, int wr, int wc, int fr, int fq) const {
        const int row0 = u.pm * BM + wr * 64 + fr, col0 = u.pn * BM + wc * 32 + 8 * fq;
#pragma unroll
        for (int ai = 0; ai < 2; ++ai)
#pragma unroll
            for (int m = 0; m < 4; ++m) { const size_t r = (size_t)(row0 + ai * HALF + m * 16);
#pragma unroll
                for (int bj = 0; bj < 2; ++bj) { const u32x4 zz = *(const u32x4*)(Z + r * ldz + col0 + bj * HALF);
                    const f32x4 a0 = acc[ai][bj][m][0], a1 = acc[ai][bj][m][1];
                    u32x4 w; w.x = cvt_pk_bf16(a0[0] * siluf(bflo(zz.x)), a0[1] * siluf(bfhi(zz.x))); w.y = cvt_pk_bf16(a0[2] * siluf(bflo(zz.y)), a0[3] * siluf(bfhi(zz.y)));
                    w.z = cvt_pk_bf16(a1[0] * siluf(bflo(zz.z)), a1[1] * siluf(bfhi(zz.z))); w.w = cvt_pk_bf16(a1[2] * siluf(bflo(zz.w)), a1[3] * siluf(bfhi(zz.w)));
                    *(u32x4*)(O + r * ldc + col0 + bj * HALF) = w; } }
    }
};
struct EpiRes {
    static constexpr bool PERM = false;
    const float* base; float* out; int ldc; float alpha;
    DI void operator()(const f32x4 (&acc)[2][2][4][2], const Unit& u, int wr, int wc, int fr, int fq) const {
        const int row0 = u.pm * BM + wr * 64 + fr, col0 = u.pn * BM + wc * 32 + 4 * fq;
#pragma unroll
        for (int ai = 0; ai < 2; ++ai)
#pragma unroll
            for (int m = 0; m < 4; ++m) { const size_t off = (size_t)(row0 + ai * HALF + m * 16) * ldc + col0;
#pragma unroll
                for (int bj = 0; bj < 2; ++bj)
#pragma unroll
                    for (int n = 0; n < 2; ++n) { const f32x4 bs = *(const f32x4*)(base + off + bj * HALF + n * 16); *(f32x4*)(out + off + bj * HALF + n * 16) = bs * alpha + acc[ai][bj][m][n]; }
                asm volatile("" ::: "memory"); }
    }
};
struct EpiGate {
    static constexpr bool PERM = true;
    bf16_t* HH; const float* ssq; const float* hg;
    DI void operator()(const f32x4 (&acc)[2][2][4][2], const Unit& u, int wr, int wc, int fr, int fq) const {
        const int row0 = u.pm * BM + wr * 64 + fr, col0 = u.pn * 128 + wc * 32 + 8 * fq, head = u.pn >> 2;
        const f32x4 g0 = *(const f32x4*)(hg + col0), g1 = *(const f32x4*)(hg + col0 + 4);
#pragma unroll
        for (int ai = 0; ai < 2; ++ai)
#pragma unroll
            for (int m = 0; m < 4; ++m) { const size_t r = (size_t)(row0 + ai * HALF + m * 16);
                const f32x4* sp = (const f32x4*)(ssq + (r * 4 + head) * 16);
                f32x4 s4 = sp[0];
#pragma unroll
                for (int q = 1; q < 4; ++q) s4 += sp[q];
                const float rs = __builtin_amdgcn_rsqf((s4[0] + s4[1] + s4[2] + s4[3]) * (1.f / 512.f) + LN_EPS);
                const u32x4 hh = *(const u32x4*)(HH + r * 2048 + col0);
                const f32x4 o0 = acc[ai][0][m][0], o1 = acc[ai][0][m][1], z0 = acc[ai][1][m][0], z1 = acc[ai][1][m][1];
                u32x4 w;
                w.x = cvt_pk_bf16(bflo(hh.x) * rs * g0[0] * sigmf(o0[0]) * siluf(z0[0]), bfhi(hh.x) * rs * g0[1] * sigmf(o0[1]) * siluf(z0[1]));
                w.y = cvt_pk_bf16(bflo(hh.y) * rs * g0[2] * sigmf(o0[2]) * siluf(z0[2]), bfhi(hh.y) * rs * g0[3] * sigmf(o0[3]) * siluf(z0[3]));
                w.z = cvt_pk_bf16(bflo(hh.z) * rs * g1[0] * sigmf(o1[0]) * siluf(z1[0]), bfhi(hh.z) * rs * g1[1] * sigmf(o1[1]) * siluf(z1[1]));
                w.w = cvt_pk_bf16(bflo(hh.w) * rs * g1[2] * sigmf(o1[2]) * siluf(z1[2]), bfhi(hh.w) * rs * g1[3] * sigmf(o1[3]) * siluf(z1[3]));
                *(u32x4*)(HH + r * 2048 + col0) = w; }
    }
};
}

#define XB_TMO      128
#define XB_XCNT(j)  (256  + 64 * (j))
#define XB_XSUB(j)  (1280 + 64 * (j))
#define XB_XGEN(j)  (2304 + 64 * (j))
#define XB_TOP      3328
#define XB_TOPGEN   3392
#define XCD_BAR_WORDS 3456
#define XB_SPIN_CAP (1u << 18)
DI unsigned xb_ld(unsigned* p)              { return __hip_atomic_load(p, __ATOMIC_RELAXED, __HIP_MEMORY_SCOPE_AGENT); }
DI unsigned xb_add(unsigned* p, unsigned v) { return __hip_atomic_fetch_add(p, v, __ATOMIC_RELAXED, __HIP_MEMORY_SCOPE_AGENT); }
DI unsigned xb_xcc_id() { return (unsigned)__builtin_amdgcn_s_getreg((3 << 11) | 20) & 0xFu; }
#define XB_SPIN(cond, bar) do { unsigned _sp = 0; while (cond) { __builtin_amdgcn_s_sleep(1); \
    if ((++_sp & 255u) == 0u) { if (xb_ld(&(bar)[XB_TMO])) break; if (_sp > XB_SPIN_CAP) { atomicAdd(&(bar)[XB_TMO], 1u); break; } } } } while (0)
struct XcdBarrier { unsigned* bar; unsigned x; volatile LAS unsigned* st; };
DI XcdBarrier xcd_barrier_post(unsigned* bar, volatile LAS unsigned* st) {
    XcdBarrier b; b.bar = bar; b.x = xb_xcc_id(); b.st = st;
    if (threadIdx.x == 0) (void)xb_add(&bar[XB_XCNT(b.x)], 1u);
    return b;
}
DI void xcd_barrier_complete(unsigned* bar, unsigned x, unsigned& nloc, unsigned& nx) {
    const unsigned G = gridDim.x * gridDim.y * gridDim.z;
    unsigned sum, cnt, mine, sp = 0u;
    for (;;) {
        sum = 0u; cnt = 0u; mine = 0u;
#pragma unroll
        for (unsigned j = 0; j < 16; ++j) { const unsigned c = xb_ld(&bar[XB_XCNT(j)]); sum += c; cnt += (c > 0u) ? 1u : 0u; mine = (j == x) ? c : mine; }
        if (sum == G) break;
        __builtin_amdgcn_s_sleep(1);
        if ((++sp & 255u) == 0u) { if (xb_ld(&bar[XB_TMO])) break; if (sp > XB_SPIN_CAP) { atomicAdd(&bar[XB_TMO], 1u); break; } }
    }
    nloc = mine > 0u ? mine : 1u; nx = cnt > 0u ? cnt : 1u;
}
DI void xcd_barrier(const XcdBarrier& b) {
    asm volatile("s_waitcnt vmcnt(0)" ::: "memory");
    __syncthreads();
    if (threadIdx.x == 0) {
        unsigned* bar = b.bar;
        __builtin_amdgcn_s_waitcnt(0);
        unsigned nloc = b.st[0], nx = b.st[1];
        if (nloc == 0u) { xcd_barrier_complete(bar, b.x, nloc, nx); b.st[0] = nloc; b.st[1] = nx; }
        const unsigned old = xb_add(&bar[XB_XSUB(b.x)], 1u);
        const unsigned gen = old / nloc;
        if (old + 1u == (gen + 1u) * nloc) {
            __builtin_amdgcn_fence(__ATOMIC_RELEASE, "agent");
            asm volatile("s_waitcnt vmcnt(0)" ::: "memory");
            const unsigned og = xb_add(&bar[XB_TOP], 1u);
            const unsigned tg = og / nx;
            if (og + 1u == (tg + 1u) * nx) xb_add(&bar[XB_TOPGEN], 1u);
            else XB_SPIN(xb_ld(&bar[XB_TOPGEN]) == tg, bar);
            __builtin_amdgcn_fence(__ATOMIC_ACQUIRE, "agent");
            xb_add(&bar[XB_XGEN(b.x)], 1u);
            asm volatile("s_waitcnt vmcnt(0)" ::: "memory");
        } else {
            XB_SPIN(xb_ld(&bar[XB_XGEN(b.x)]) == gen, bar);
            __builtin_amdgcn_fence(__ATOMIC_ACQUIRE, "agent");
            asm volatile("s_waitcnt vmcnt(0)" ::: "memory");
        }
    }
    __syncthreads();
}

struct Frame {
    LAS unsigned char* lds;
    int tid, lane, wave, G;
    const float *x, *a_w_in, *a_kv_g, *a_w_uk, *a_w_uv, *a_w_out, *a_ln_g, *a_ln_b;
    const float *b_w_in, *b_i_bias, *b_f_bias, *b_conv_w, *b_conv_b, *b_hn_g, *b_w_out, *b_ln_g, *b_ln_b;
    float* out; unsigned char* ws;
};

DI void p0_item(const float* W, int ldw, int c0, int nvalid, bf16* WT, int ldt, int drow, int dcol0, LAS float* scr, int k0, int n0, int lane) {
    const bool ok = (n0 + (lane & 31)) < nvalid;
#pragma unroll 8
    for (int i = 0; i < 32; ++i) { const int kk = 2 * i + (lane >> 5); scr[kk * 33 + (lane & 31)] = ok ? W[(size_t)(k0 + kk) * ldw + c0 + n0 + (lane & 31)] : 0.f; }
    LDS_WAIT(); asm volatile("" ::: "memory");
    const int c = lane & 7;
#pragma unroll
    for (int j = 0; j < 4; ++j) { const int n = (lane >> 3) + 8 * j; const LAS float* s = scr + (8 * c) * 33 + n;
        u32x4 o; o.x = pk2(s[0 * 33], s[1 * 33]); o.y = pk2(s[2 * 33], s[3 * 33]); o.z = pk2(s[4 * 33], s[5 * 33]); o.w = pk2(s[6 * 33], s[7 * 33]);
        *(u32x4*)(WT + (size_t)(drow + n) * ldt + dcol0 + k0 + 8 * c) = o; }
    LDS_WAIT(); asm volatile("" ::: "memory");
}
DI void p0_prologue(Frame& F) {
    LAS float* scr = (LAS float*)(F.lds + F.wave * 16384);
    const int gw = blockIdx.x * 8 + F.wave, NGW = F.G * 8, lane = F.lane;
    bf16* WA = (bf16*)(F.ws + WS_WA); bf16* WUK = (bf16*)(F.ws + WS_WUK); bf16* WUVB = (bf16*)(F.ws + WS_WUVB); bf16* WAO = (bf16*)(F.ws + WS_WAO);
    bf16* WBI = (bf16*)(F.ws + WS_WBI); bf16* WBO = (bf16*)(F.ws + WS_WBO);
    constexpr int I0 = 16 * 64, I1 = 16 * 32, I2 = 128, I3 = 128, I4 = 16 * 32, I5 = 16 * 128, I6 = 16 * 64, I7 = 16 * 64, I8 = 32 * 32;
    constexpr int NIT = I0 + I1 + I2 + I3 + I4 + I5 + I6 + I7 + I8;
    for (int it = gw; it < NIT; it += NGW) {
        int r = it;
        if (r < I0) { const int kb = r / 64, nb = r % 64; p0_item(F.a_w_in, A_IN, 0, 1864, WA, 1024, 32 * nb, 0, scr, 64 * kb, 32 * nb, lane); continue; } r -= I0;
        if (r < I1) { const int kb = r / 32, nb = r % 32; p0_item(F.a_w_in, A_IN, 1864, 1024, WA, 1024, 2048 + 32 * nb, 0, scr, 64 * kb, 32 * nb, lane); continue; } r -= I1;
        if (r < I2) { const int h = r / 16, q = r % 16, kb = q / 8, nb = q % 8; p0_item(F.a_w_uk + (size_t)h * 128 * 256, 256, 0, 256, WUK, 128, h * 256 + 32 * nb, 0, scr, 64 * kb, 32 * nb, lane); continue; } r -= I2;
        if (r < I3) { const int h = r / 16, q = r % 16, kb = q / 4, nb = q % 4; p0_item(F.a_w_uv + (size_t)h * 256 * 128, 128, 0, 128, WUVB, 512, h * 128 + 32 * nb, (h & 1) * 256, scr, 64 * kb, 32 * nb, lane); continue; } r -= I3;
        if (r < I4) { const int kb = r / 32, nb = r % 32; p0_item(F.a_w_out, 1024, 0, 1024, WAO, 1024, 32 * nb, 0, scr, 64 * kb, 32 * nb, lane); continue; } r -= I4;
        if (r < I5) { const int kb = r / 128, nb = r % 128; p0_item(F.b_w_in, B_IN, 0, 4096, WBI, 1024, 32 * nb, 0, scr, 64 * kb, 32 * nb, lane); continue; } r -= I5;
        if (r < I6) { const int kb = r / 64, nb = r % 64; p0_item(F.b_w_in, B_IN, 4104, 2048, WBI, 1024, 4096 + 256 * (nb >> 2) + 32 * (nb & 3), 0, scr, 64 * kb, 32 * nb, lane); continue; } r -= I6;
        if (r < I7) { const int kb = r / 64, nb = r % 64; p0_item(F.b_w_in, B_IN, 6152, 2048, WBI, 1024, 4096 + 256 * (nb >> 2) + 128 + 32 * (nb & 3), 0, scr, 64 * kb, 32 * nb, lane); continue; } r -= I7;
        { const int kb = r / 32, nb = r % 32; p0_item(F.b_w_out, 1024, 0, 1024, WBO, 2048, 32 * nb, 0, scr, 64 * kb, 32 * nb, lane); }
    }
    const size_t gt = (size_t)blockIdx.x * 512 + F.tid, NT = (size_t)F.G * 512;
    for (size_t i = gt; i < 1024 * 32; i += NT) { const int n = (int)(i >> 5), c = (int)(i & 31), h = n >> 7; *(u32x4*)(WUVB + (size_t)n * 512 + ((h & 1) ^ 1) * 256 + c * 8) = (u32x4){0u, 0u, 0u, 0u}; }
    float* WGp = (float*)(F.ws + WS_WG);
    for (size_t i = gt; i < 8 * 1024; i += NT) { const int j = (int)(i >> 10), k = (int)(i & 1023); WGp[i] = F.b_w_in[(size_t)k * B_IN + 4096 + j]; }
    bf16* XB = (bf16*)(F.ws + WS_XB);
    for (size_t i = gt; i < (size_t)M * D / 8; i += NT) { const f32x4 a = *(const f32x4*)(F.x + i * 8), b = *(const f32x4*)(F.x + i * 8 + 4);
        u32x4 o; o.x = pk2(a[0], a[1]); o.y = pk2(a[2], a[3]); o.z = pk2(b[0], b[1]); o.w = pk2(b[2], b[3]); *(u32x4*)(XB + i * 8) = o; }
}

DI void p2_ckv(Frame& F) {
    const bf16* PA1 = (const bf16*)(F.ws + WS_PA1); bf16* CKV = (bf16*)(F.ws + WS_CKV);
    const int gw = blockIdx.x * 8 + F.wave, NGW = F.G * 8, lane = F.lane;
    const f32x4 g = *(const f32x4*)(F.a_kv_g + lane * 4);
    for (int tok = gw; tok < M; tok += NGW) {
        const u32x2 raw = *(const u32x2*)(PA1 + (size_t)tok * 2048 + 1024 + lane * 4);
        const float v0 = bflo(raw.x), v1 = bfhi(raw.x), v2 = bflo(raw.y), v3 = bfhi(raw.y);
        const float ss = wave_sum(v0 * v0 + v1 * v1 + v2 * v2 + v3 * v3);
        const float r = 1.f / sqrtf(ss * (1.f / 256.f) + LN_EPS);
        u32x2 o; o.x = pk2(v0 * r * g[0], v1 * r * g[1]); o.y = pk2(v2 * r * g[2], v3 * r * g[3]);
        *(u32x2*)(CKV + (size_t)tok * 256 + lane * 4) = o;
    }
}

DI void p3_index_topk(Frame& F) {
    const bf16* PA1 = (const bf16*)(F.ws + WS_PA1); const bf16* KIDX = (const bf16*)(F.ws + WS_KIDX); short* SEL = (short*)(F.ws + WS_SEL);
    LAS float* S = (LAS float*)F.lds;
    LAS short* sb = (LAS short*)(F.lds + AUX_OFF) + F.wave * 320;
    const int lane = F.lane, wave = F.wave, fr = lane & 15, fq = lane >> 4;
    const unsigned long long lt_mask = (1ull << lane) - 1ull;
    for (int idx = blockIdx.x; idx < 2048; idx += F.G) {
        const int i = idx >> 8, w = idx & 255, b = i >> 1, r = (i & 1) ? (511 - w) : w;
        const int t0 = r * 8, tok0 = b * T + t0;
        bf16x8 af[2][2][2]; float wv[2][8];
#pragma unroll
        for (int mi = 0; mi < 2; ++mi) {
#pragma unroll
            for (int hb = 0; hb < 2; ++hb)
#pragma unroll
                for (int ks = 0; ks < 2; ++ks) af[mi][hb][ks] = *(const bf16x8*)(PA1 + (size_t)(tok0 + 4 * mi + (fr >> 2)) * 2048 + 1280 + (4 * hb + (fr & 3)) * 64 + ks * 32 + fq * 8);
            const u32x4 raw = *(const u32x4*)(PA1 + (size_t)(tok0 + 4 * mi + fq) * 2048 + 1856);
            wv[mi][0] = bflo(raw.x); wv[mi][1] = bfhi(raw.x); wv[mi][2] = bflo(raw.y); wv[mi][3] = bfhi(raw.y); wv[mi][4] = bflo(raw.z); wv[mi][5] = bfhi(raw.z); wv[mi][6] = bflo(raw.w); wv[mi][7] = bfhi(raw.w);
        }
        const int nkt = (t0 + 8 + 15) >> 4, nrounds = (nkt + 31) >> 5;
        const bf16* kbase = KIDX + (size_t)(b * T + fr) * 64 + fq * 8;
        bf16x8 kb[4][2], nkb[4][2];
#pragma unroll
        for (int i = 0; i < 4; ++i) { int kt = 4 * wave + i; kt = kt > 255 ? 255 : kt; kb[i][0] = *(const bf16x8*)(kbase + (size_t)kt * 16 * 64); kb[i][1] = *(const bf16x8*)(kbase + (size_t)kt * 16 * 64 + 32); }
        REP(15) for (int r = 0; r < nrounds; ++r) {
#pragma unroll
            for (int i = 0; i < 4; ++i) { int kt = 32 * (r + 1) + 4 * wave + i; kt = kt > 255 ? 255 : kt; nkb[i][0] = *(const bf16x8*)(kbase + (size_t)kt * 16 * 64); nkb[i][1] = *(const bf16x8*)(kbase + (size_t)kt * 16 * 64 + 32); }
            f32x4 ac[4][2][2];
#pragma unroll
            for (int i = 0; i < 4; ++i)
#pragma unroll
                for (int mi = 0; mi < 2; ++mi)
#pragma unroll
                    for (int hb = 0; hb < 2; ++hb) ac[i][mi][hb] = __builtin_amdgcn_mfma_f32_16x16x32_bf16(af[mi][hb][0], kb[i][0], (f32x4){0.f, 0.f, 0.f, 0.f}, 0, 0, 0);
#pragma unroll
            for (int i = 0; i < 4; ++i)
#pragma unroll
                for (int mi = 0; mi < 2; ++mi)
#pragma unroll
                    for (int hb = 0; hb < 2; ++hb) ac[i][mi][hb] = __builtin_amdgcn_mfma_f32_16x16x32_bf16(af[mi][hb][1], kb[i][1], ac[i][mi][hb], 0, 0, 0);
#pragma unroll
            for (int i = 0; i < 4; ++i) {
                int kt = 32 * r + 4 * wave + i; kt = kt > 255 ? 255 : kt;
#pragma unroll
                for (int mi = 0; mi < 2; ++mi) {
                    const f32x4 a0 = ac[i][mi][0], a1 = ac[i][mi][1];
                    const float sc = (wv[mi][0] * fmaxf(a0[0], 0.f) + wv[mi][1] * fmaxf(a0[1], 0.f)) + (wv[mi][2] * fmaxf(a0[2], 0.f) + wv[mi][3] * fmaxf(a0[3], 0.f))
                                   + (wv[mi][4] * fmaxf(a1[0], 0.f) + wv[mi][5] * fmaxf(a1[1], 0.f)) + (wv[mi][6] * fmaxf(a1[2], 0.f) + wv[mi][7] * fmaxf(a1[3], 0.f));
                    S[(4 * mi + fq) * 4096 + kt * 16 + fr] = sc;
                }
            }
#pragma unroll
            for (int i = 0; i < 4; ++i) { kb[i][0] = nkb[i][0]; kb[i][1] = nkb[i][1]; }
        }
        __syncthreads();
        {
            const int t = t0 + wave;
            unsigned key[64];
            int ln = lane; asm volatile("" : "+v"(ln));
            const int tl_ = t - ln; const LAS float* srow = S + wave * 4096 + ln;
#pragma unroll
            for (int j = 0; j < 64; ++j) { const float v = srow[j * 64] + 0.0f; unsigned u = __float_as_uint(v); u = (u & 0x80000000u) ? ~u : (u | 0x80000000u); key[j] = (j * 64 <= tl_) ? u : 0u; }
            unsigned Tk = 0u; int nties = 0;
            REP(14) if (t + 1 > 256) {
                LAS unsigned* hist = (LAS unsigned*)(S + wave * 4096);
                unsigned prefix = 0u; int need = 256;
#pragma unroll 1
                for (int lvl = 0; lvl < 3; ++lvl) {
                    const int sh = (lvl == 0) ? 21 : ((lvl == 1) ? 10 : 0);
                    const unsigned nbm = (lvl == 2) ? 1023u : 2047u;
                    const unsigned himask = (lvl == 0) ? 0u : ((lvl == 1) ? 0xFFE00000u : 0xFFFFFC00u);
#pragma unroll
                    for (int i = 0; i < 8; ++i) *(LAS u32x4*)(hist + (i * 64 + lane) * 4) = (u32x4){0u, 0u, 0u, 0u};
#pragma unroll
                    for (int j = 0; j < 64; ++j) { const unsigned k = key[j]; const unsigned bb = (k >> sh) & nbm;
                        const unsigned widx = (k != 0u && (k & himask) == prefix) ? (bb ^ ((bb >> 5) & 31u)) : (2048u + (unsigned)lane);
                        (void)__hip_atomic_fetch_add(hist + widx, 1u, __ATOMIC_RELAXED, __HIP_MEMORY_SCOPE_WORKGROUP); if ((j & 7) == 7) __builtin_amdgcn_sched_barrier(0); }
                    LDS_WAIT(); asm volatile("" ::: "memory");
                    unsigned ls = 0u;
#pragma unroll
                    for (int i = 0; i < 32; ++i) { const unsigned bb = 32u * lane + i; ls += hist[bb ^ ((bb >> 5) & 31u)]; if ((i & 7) == 7) __builtin_amdgcn_sched_barrier(0); }
                    const unsigned pre = wave_prefix_incl(ls);
                    const unsigned suf = (unsigned)__builtin_amdgcn_readlane((int)pre, 63) - pre + ls;
                    const unsigned long long m1 = __ballot(suf >= (unsigned)need);
                    const int L = 63 - __clzll((long long)m1);
                    const unsigned above = (unsigned)__builtin_amdgcn_readlane((int)suf, (L < 63) ? L + 1 : 63);
                    const int need2 = need - ((L < 63) ? (int)above : 0);
                    const unsigned bb2 = 32u * (unsigned)L + (unsigned)(lane & 31);
                    unsigned c2 = hist[bb2 ^ ((bb2 >> 5) & 31u)]; if (lane >= 32) c2 = 0u;
                    const unsigned pre2 = wave_prefix_incl(c2);
                    const unsigned suf2 = (unsigned)__builtin_amdgcn_readlane((int)pre2, 63) - pre2 + c2;
                    const unsigned long long m2 = __ballot(lane < 32 && suf2 >= (unsigned)need2);
                    const int I = 63 - __clzll((long long)m2);
                    const unsigned above2 = (unsigned)__builtin_amdgcn_readlane((int)suf2, (I < 31) ? I + 1 : 31);
                    const unsigned cnt_tb = (unsigned)__builtin_amdgcn_readlane((int)c2, I);
                    need = need2 - ((I < 31) ? (int)above2 : 0);
                    prefix |= (32u * (unsigned)L + (unsigned)I) << sh;
                    LDS_WAIT(); asm volatile("" ::: "memory");
                    if ((int)cnt_tb == need) { Tk = prefix - 1u; nties = 0; break; }
                    if (lvl == 2) { Tk = prefix; nties = need; }
                }
            }
            int xl = -1 - lane;
            if (nties > 0) {
                int X = 0;
                for (int bit = 11; bit >= 0; --bit) {
                    const int cand = X | (1 << bit), cl = cand - 1 - lane; int cnt = 0;
#pragma unroll
                    for (int j = 0; j < 64; ++j) { cnt += (key[j] == Tk && j * 64 <= cl) ? 1 : 0; if ((j & 7) == 7) __builtin_amdgcn_sched_barrier(0); }
                    if (wave_sum_small(cnt) < nties) X = cand;
                }
                xl = X - lane;
            }
            int cg = 0;
#pragma unroll
            for (int j = 0; j < 64; ++j) { cg += (key[j] > Tk || (key[j] == Tk && j * 64 <= xl)) ? 1 : 0; if ((j & 7) == 7) __builtin_amdgcn_sched_barrier(0); }
            const int cgt = wave_sum_small(cg);
            int pos = (int)wave_prefix_incl((unsigned)cg) - cg;
            int ln2 = lane; asm volatile("" : "+v"(ln2));
#pragma unroll
            for (int j = 0; j < 64; ++j) { const bool sel = key[j] > Tk || (key[j] == Tk && j * 64 <= xl); sb[sel ? pos : 256 + ln2] = (short)(j * 64 + ln2); pos += sel ? 1 : 0; if ((j & 7) == 7) __builtin_amdgcn_sched_barrier(0); }
            nties = 0;
            const int total = cgt + nties;
            for (int p = total + lane; p < 256; p += 64) sb[p] = (short)-1;
            LDS_WAIT(); asm volatile("" ::: "memory");
            const u32x2 o = *(const LAS u32x2*)(sb + 4 * lane);
            *(u32x2*)(SEL + (size_t)(tok0 + wave) * 256 + 4 * lane) = o;
        }
        __syncthreads();
    }
}

DI int cimg(int row, int piece) { return row * 512 + ((piece ^ ((row & 7) << 1)) << 4); }
DI float xrow_max(float x) {
    auto a = __builtin_amdgcn_permlane16_swap(__float_as_uint(x), __float_as_uint(x), false, false); x = fmaxf(__uint_as_float(a[0]), __uint_as_float(a[1]));
    auto b = __builtin_amdgcn_permlane32_swap(__float_as_uint(x), __float_as_uint(x), false, false); return fmaxf(__uint_as_float(b[0]), __uint_as_float(b[1]));
}
DI float xrow_sum(float x) {
    auto a = __builtin_amdgcn_permlane16_swap(__float_as_uint(x), __float_as_uint(x), false, false); x = __uint_as_float(a[0]) + __uint_as_float(a[1]);
    auto b = __builtin_amdgcn_permlane32_swap(__float_as_uint(x), __float_as_uint(x), false, false); return __uint_as_float(b[0]) + __uint_as_float(b[1]);
}
DI void p4_attention(Frame& F) {
    const bf16* CKV = (const bf16*)(F.ws + WS_CKV); const bf16* QLAT = (const bf16*)(F.ws + WS_QLAT); const short* SEL = (const short*)(F.ws + WS_SEL);
    bf16* OLAT = (bf16*)(F.ws + WS_PA1);
    const int lane = F.lane, wave = F.wave, fr = lane & 15, fq = lane >> 4;
    LAS unsigned char* img0 = F.lds + wave * 16384;
    LAS short* sb = (LAS short*)(F.lds + AUX_OFF) + wave * 320;
    const float slope = (fr < 8) ? exp2f(-(float)(fr + 1)) : 0.f;
    const int q4 = (lane & 15) >> 2, p4 = lane & 3;
    const int NW = F.G * 8;
    for (int it = 0; it < (M + NW - 1) / NW; ++it) {
        int tok;
        if (F.G == 256) { const int xcd = blockIdx.x & 7, bb = xcd >> 1, ib = (blockIdx.x >> 3) * 2 + (xcd & 1); tok = bb * T + (ib * 8 + wave) + 512 * it; }
        else tok = (blockIdx.x * 8 + wave) + NW * it;
        if (tok >= M) break;
        const int b = tok / T, t = tok % T;
        bf16x8 bq[8];
#pragma unroll
        for (int ks = 0; ks < 8; ++ks) bq[ks] = (fr < 8) ? *(const bf16x8*)(QLAT + (size_t)tok * 2048 + fr * 256 + ks * 32 + fq * 8) : (bf16x8){0, 0, 0, 0, 0, 0, 0, 0};
        { const u32x2 sv = *(const u32x2*)(SEL + (size_t)tok * 256 + 4 * lane); *(LAS u32x2*)(sb + 4 * lane) = sv; }
        LDS_WAIT(); asm volatile("" ::: "memory");
        const int nvalid = (t + 1 < 256) ? (t + 1) : 256;
        const int nch = (nvalid + 15) >> 4;
        const bf16* ckb = CKV + (size_t)b * T * 256 + (lane & 31) * 8;
        f32x4 oacc[16];
#pragma unroll
        for (int n = 0; n < 16; ++n) oacc[n] = (f32x4){0.f, 0.f, 0.f, 0.f};
        float m_run = -INFINITY, l_run = 0.f;
        u32x4 g[8];
#define P4_GATHER(cc) do { _Pragma("unroll") for (int rr = 0; rr < 8; ++rr) { int kid = sb[16 * (cc) + 2 * rr + (lane >> 5)]; kid = kid < 0 ? 0 : kid; g[rr] = *(const u32x4*)(ckb + (size_t)kid * 256); } } while (0)
#define P4_STORE(buf) do { _Pragma("unroll") for (int rr = 0; rr < 8; ++rr) *(LAS u32x4*)((buf) + cimg(2 * rr + (lane >> 5), lane & 31)) = g[rr]; } while (0)
        P4_GATHER(0);
        P4_STORE(img0);
#pragma unroll 1
        for (int ch = 0; ch < nch; ++ch) {
            LAS unsigned char* img = img0 + (ch & 1) * 8192;
            if (ch + 1 < nch) P4_GATHER(ch + 1);
            f32x4 lg = (f32x4){0.f, 0.f, 0.f, 0.f};
#pragma unroll
            for (int ks = 0; ks < 8; ++ks) { const bf16x8 a = *(const LAS bf16x8*)(img + cimg(fr, 4 * ks + fq)); lg = __builtin_amdgcn_mfma_f32_16x16x32_bf16(a, bq[ks], lg, 0, 0, 0); }
            const s16x4 kp = *(const LAS s16x4*)(sb + 16 * ch + 4 * fq);
#pragma unroll
            for (int rg = 0; rg < 4; ++rg) { const int kid = kp[rg]; lg[rg] = (kid >= 0) ? (lg[rg] - slope * (float)(t - kid)) : -INFINITY; }
            const float cmax = xrow_max(fmaxf(fmaxf(lg[0], lg[1]), fmaxf(lg[2], lg[3])));
            const float m_new = fmaxf(m_run, cmax);
            float p[4]; float ps = 0.f;
#pragma unroll
            for (int rg = 0; rg < 4; ++rg) { p[rg] = __expf(lg[rg] - m_new); ps += p[rg]; }
            ps = xrow_sum(ps);
            if (__ballot(m_new > m_run) != 0ull) {
                const float alpha = __expf(m_run - m_new);
                l_run *= alpha;
                float ah[4];
#pragma unroll
                for (int rg = 0; rg < 4; ++rg) ah[rg] = __shfl(alpha, 4 * fq + rg);
#pragma unroll
                for (int n = 0; n < 16; ++n) { oacc[n][0] *= ah[0]; oacc[n][1] *= ah[1]; oacc[n][2] *= ah[2]; oacc[n][3] *= ah[3]; }
            }
            l_run += ps; m_run = m_new;
            const s16x4 pa = __builtin_bit_cast(s16x4, (u32x2){pk2(p[0], p[1]), pk2(p[2], p[3])});
#pragma unroll
            for (int n = 0; n < 16; ++n) {
                const s16x4 bv = __builtin_amdgcn_ds_read_tr16_b64_v4i16((LAS s16x4*)(img + cimg(4 * fq + q4, 2 * n + (p4 >> 1)) + 8 * (p4 & 1)));
                oacc[n] = __builtin_amdgcn_mfma_f32_16x16x16bf16_1k(pa, bv, oacc[n], 0, 0, 0);
            }
            if (ch + 1 < nch) P4_STORE(img0 + ((ch + 1) & 1) * 8192);
        }
#undef P4_GATHER
#undef P4_STORE
        LDS_WAIT(); asm volatile("" ::: "memory");
        float lh[4];
#pragma unroll
        for (int rg = 0; rg < 4; ++rg) lh[rg] = 1.f / __shfl(l_run, 4 * fq + rg);
        if (fq < 2) {
#pragma unroll
            for (int n = 0; n < 16; ++n)
#pragma unroll
                for (int rg = 0; rg < 4; ++rg) ((LAS bf16*)img0)[(4 * fq + rg) * 256 + 16 * n + fr] = (bf16)f2bf(oacc[n][rg] * lh[rg]);
        }
        LDS_WAIT(); asm volatile("" ::: "memory");
#pragma unroll
        for (int q = 0; q < 4; ++q) { const u32x4 v = *(const LAS u32x4*)(img0 + (q * 64 + lane) * 16); *(u32x4*)(OLAT + (size_t)tok * 2048 + (q * 64 + lane) * 8) = v; }
        LDS_WAIT(); asm volatile("" ::: "memory");
    }
}

template <bool FIRST>
DI void p_ln_rows(Frame& F, const float* gam, const float* bet) {
    float* U = F.out; bf16* X1B = (bf16*)(F.ws + WS_XB); const float* WGp = (const float*)(F.ws + WS_WG); float* GATES = (float*)(F.ws + WS_GATES);
    const int gw = blockIdx.x * 8 + F.wave, NGW = F.G * 8, lane = F.lane;
    f32x4 gv[4], bv[4];
#pragma unroll
    for (int j = 0; j < 4; ++j) { gv[j] = *(const f32x4*)(gam + 4 * lane + 256 * j); bv[j] = *(const f32x4*)(bet + 4 * lane + 256 * j); }
    for (int tok = gw; tok < M; tok += NGW) {
        f32x4 v[4]; float s = 0.f;
#pragma unroll
        for (int j = 0; j < 4; ++j) { v[j] = *(const f32x4*)(U + (size_t)tok * D + 4 * lane + 256 * j); s += (v[j][0] + v[j][1]) + (v[j][2] + v[j][3]); }
        const float mean = wave_sum(s) * (1.f / D); float s2 = 0.f;
#pragma unroll
        for (int j = 0; j < 4; ++j) { v[j] = v[j] - mean; s2 += (v[j][0] * v[j][0] + v[j][1] * v[j][1]) + (v[j][2] * v[j][2] + v[j][3] * v[j][3]); }
        const float rstd = 1.f / sqrtf(wave_sum(s2) * (1.f / D) + LN_EPS);
#pragma unroll
        for (int j = 0; j < 4; ++j) { v[j] = v[j] * rstd * gv[j] + bv[j]; *(f32x4*)(U + (size_t)tok * D + 4 * lane + 256 * j) = v[j]; }
        if (FIRST) {
#pragma unroll
            for (int j = 0; j < 4; ++j) { u32x2 o; o.x = pk2(v[j][0], v[j][1]); o.y = pk2(v[j][2], v[j][3]); *(u32x2*)(X1B + (size_t)tok * D + 4 * lane + 256 * j) = o; }
            float gsum = 0.f;
#pragma unroll
            for (int jg = 0; jg < 8; ++jg) { float d = 0.f;
#pragma unroll
                for (int j = 0; j < 4; ++j) { const f32x4 w = *(const f32x4*)(WGp + jg * 1024 + 4 * lane + 256 * j); d += (v[j][0] * w[0] + v[j][1] * w[1]) + (v[j][2] * w[2] + v[j][3] * w[3]); }
                d = wave_sum(d); gsum = (lane == jg) ? d : gsum; }
            if (lane < 8) GATES[(size_t)tok * 8 + lane] = gsum;
        }
    }
}

constexpr int QS_STRIDE = 272;
DI float block_scan_add(float v, LAS float* wtot, int lane, int wave) {
#pragma unroll
    for (int d = 1; d < 64; d <<= 1) { const float t = __shfl_up(v, d); if (lane >= d) v += t; }
    if (lane == 63) wtot[wave] = v;
    __syncthreads();
    float off = 0.f;
#pragma unroll
    for (int w = 0; w < 8; ++w) off += (w < wave) ? wtot[w] : 0.f;
    __syncthreads();
    return v + off;
}
DI float block_scan_max(float v, LAS float* wtot, int lane, int wave) {
#pragma unroll
    for (int d = 1; d < 64; d <<= 1) { const float t = __shfl_up(v, d); if (lane >= d) v = fmaxf(v, t); }
    if (lane == 63) wtot[wave] = v;
    __syncthreads();
    float off = -INFINITY;
#pragma unroll
    for (int w = 0; w < 8; ++w) off = (w < wave) ? fmaxf(off, wtot[w]) : off;
    __syncthreads();
    return fmaxf(v, off);
}
DI void p9_chunk_prep(Frame& F) {
    const bf16* QKPRE = (const bf16*)(F.ws + WS_PA1); const float* GATES = (const float*)(F.ws + WS_GATES);
    bf16* QG = (bf16*)(F.ws + WS_QG); bf16* KT = (bf16*)(F.ws + WS_KT); bf16* SS = (bf16*)(F.ws + WS_SS);
    float* EXPM = (float*)(F.ws + WS_EXPM); float* DEC = (float*)(F.ws + WS_DEC);
    LAS float* Fa = (LAS float*)F.lds;
    LAS float* Aa = Fa + 4096;
    LAS float* Ga = Aa + 4096;
    LAS bf16* qs = (LAS bf16*)(F.lds + 49152);
    LAS bf16* ks = qs + 64 * QS_STRIDE;
    LAS float* wtot = (LAS float*)(F.lds + AUX_OFF);
    const int tid = F.tid, lane = F.lane, wave = F.wave, fr = lane & 15, fq = lane >> 4;
    for (int grp = blockIdx.x; grp < 256; grp += F.G) {
        const int bh = grp >> 4, b = bh >> 2, h = bh & 3;
        const float ib = F.b_i_bias[h], fb = F.b_f_bias[h];
        __syncthreads();
        {
            float lf[8], run = 0.f;
#pragma unroll
            for (int e = 0; e < 8; ++e) { const float xg = GATES[(size_t)(b * T + 8 * tid + e) * 8 + 4 + h] + fb;
                const float ls = fminf(xg, 0.f) - log1pf(__expf(-fabsf(xg))); run += ls; lf[e] = run; }
            const float incl = block_scan_add(run, wtot, lane, wave); const float off = incl - run;
            float av[8], mx = -INFINITY;
#pragma unroll
            for (int e = 0; e < 8; ++e) { const float Fv = lf[e] + off; Fa[8 * tid + e] = Fv;
                const float a = GATES[(size_t)(b * T + 8 * tid + e) * 8 + h] + ib - Fv; Aa[8 * tid + e] = a; mx = fmaxf(mx, a); av[e] = mx; }
            const float inclm = block_scan_max(mx, wtot, lane, wave);
            LAS float* tmp = (LAS float*)(F.lds + 49152);
            tmp[tid] = inclm;
            __syncthreads();
            const float excl = (tid > 0) ? tmp[tid - 1] : -INFINITY;
#pragma unroll
            for (int e = 0; e < 8; ++e) Ga[8 * tid + e] = fmaxf(0.f, fmaxf(excl, av[e]));
            __syncthreads();
        }
        for (int cq = 0; cq < 4; ++cq) {
            const int c = (grp & 15) * 4 + cq, tb = 64 * c;
            const float Gprev = (c == 0) ? 0.f : Ga[tb - 1], Gend = Ga[tb + 63];
            if (tid == 0) DEC[bh * 64 + c] = __expf(Gprev - Gend);
            if (tid < 64) EXPM[bh * 4096 + tb + tid] = __expf(-(Fa[tb + tid] + Ga[tb + tid]));
            {
                const int p = tid & 255, rh = tid >> 8, isk = (p >= 128) ? 1 : 0, dcol = 2 * (p & 127);
                const int gcol = isk * 1024 + h * 256 + dcol;
                float w0[4], w1[4];
#pragma unroll
                for (int j = 0; j < 4; ++j) { w0[j] = F.b_conv_w[j * 2048 + gcol]; w1[j] = F.b_conv_w[j * 2048 + gcol + 1]; }
                const float cb0 = F.b_conv_b[gcol], cb1 = F.b_conv_b[gcol + 1];
                float u0[3], u1[3];
#pragma unroll
                for (int j = 0; j < 3; ++j) { const int tt = tb + 32 * rh - 3 + j; unsigned raw = 0u; if (tt >= 0) raw = *(const unsigned*)(QKPRE + (size_t)(b * T + tt) * 2048 + gcol); u0[j] = bflo(raw); u1[j] = bfhi(raw); }
                unsigned kacc0[4], kacc1[4];
                for (int r8 = 0; r8 < 4; ++r8) {
#pragma unroll
                for (int sl = 0; sl < 8; ++sl) {
                    const int rr = 8 * r8 + sl, tl = 32 * rh + rr, tt = tb + tl;
                    const unsigned raw = *(const unsigned*)(QKPRE + (size_t)(b * T + tt) * 2048 + gcol);
                    const float c0 = bflo(raw), c1 = bfhi(raw);
                    const float y0 = siluf(w0[0] * u0[0] + w0[1] * u0[1] + w0[2] * u0[2] + w0[3] * c0 + cb0);
                    const float y1 = siluf(w1[0] * u1[0] + w1[1] * u1[1] + w1[2] * u1[2] + w1[3] * c1 + cb1);
                    u0[0] = u0[1]; u0[1] = u0[2]; u0[2] = c0; u1[0] = u1[1]; u1[1] = u1[2]; u1[2] = c1;
                    if (!isk) {
                        const float q0 = y0 * 0.0625f, q1 = y1 * 0.0625f;
                        *(LAS unsigned*)(qs + tl * QS_STRIDE + dcol) = pk2(q0, q1);
                        const float gi = __expf(Gprev - Ga[tt]);
                        *(unsigned*)(QG + ((((size_t)(bh * 64 + c) * 4 + (tl >> 4)) * 8 + (dcol >> 5)) * 64 + ((dcol & 31) >> 3) * 16 + (tl & 15)) * 8 + (dcol & 7)) = pk2(q0 * gi, q1 * gi);
                    } else {
                        *(LAS unsigned*)(ks + tl * QS_STRIDE + dcol) = pk2(y0, y1);
                        const float wk = __expf(Aa[tt] - Gend);
                        const unsigned e0 = f2bf(y0 * wk), e1 = f2bf(y1 * wk);
                        if ((sl & 1) == 0) { kacc0[sl >> 1] = e0; kacc1[sl >> 1] = e1; } else { kacc0[sl >> 1] |= e0 << 16; kacc1[sl >> 1] |= e1 << 16; }
                        if ((sl & 3) == 3) {
                            const int s0 = tl - 3, u = s0 & 31, fqk = (u & 15) >> 2, jo = 4 * (u >> 4), hk = (sl >> 2) * 2;
                            bf16* kt0 = KT + ((((size_t)(bh * 64 + c) * 16 + (dcol >> 4)) * 2 + (s0 >> 5)) * 64 + fqk * 16 + (dcol & 15)) * 8 + jo;
                            *(u32x2*)kt0 = (u32x2){kacc0[hk], kacc0[hk + 1]};
                            *(u32x2*)(kt0 + 8) = (u32x2){kacc1[hk], kacc1[hk + 1]};
                        }
                    }
                }
                }
            }
            __syncthreads();
            {
                const int st = wave >> 1;
#pragma unroll
                for (int tq = 0; tq < 2; ++tq) {
                    const int tt = 2 * (wave & 1) + tq;
                    f32x4 acc = (f32x4){0.f, 0.f, 0.f, 0.f};
                    if (st <= tt) {
#pragma unroll
                        for (int kk = 0; kk < 8; ++kk) {
                            const bf16x8 a = *(const LAS bf16x8*)(ks + (16 * st + fr) * QS_STRIDE + 32 * kk + 8 * fq);
                            const bf16x8 bb = *(const LAS bf16x8*)(qs + (16 * tt + fr) * QS_STRIDE + 32 * kk + 8 * fq);
                            acc = __builtin_amdgcn_mfma_f32_16x16x32_bf16(a, bb, acc, 0, 0, 0);
                        }
                    }
                    const int tl = 16 * tt + fr; const float Gt = Ga[tb + tl];
                    float o[4];
#pragma unroll
                    for (int rg = 0; rg < 4; ++rg) { const int sl = 16 * st + 4 * fq + rg; o[rg] = (sl <= tl) ? acc[rg] * __expf(Aa[tb + sl] - Gt) : 0.f; }
                    u32x2 w; w.x = pk2(o[0], o[1]); w.y = pk2(o[2], o[3]);
                    *(u32x2*)(SS + ((((size_t)(bh * 64 + c) * 4 + tt) * 2 + (st >> 1)) * 64 + fq * 16 + fr) * 8 + 4 * (st & 1)) = w;
                }
            }
            __syncthreads();
        }
    }
}

constexpr int CT_STRIDE = 272;
constexpr int VT_STRIDE = 48;
DI void p10_scan(Frame& F) {
    const bf16* QG = (const bf16*)(F.ws + WS_QG); const bf16* KT = (const bf16*)(F.ws + WS_KT); const bf16* SS = (const bf16*)(F.ws + WS_SS);
    const bf16* V = (const bf16*)(F.ws + WS_V); const float* EXPM = (const float*)(F.ws + WS_EXPM); const float* DEC = (const float*)(F.ws + WS_DEC);
    bf16* HH = (bf16*)(F.ws + WS_PA1); float* SSQ = (float*)(F.ws + WS_SSQ);
    LAS bf16* CT = (LAS bf16*)F.lds;
    LAS bf16* VT = (LAS bf16*)(F.lds + 2 * 48 * CT_STRIDE * 2);
    const int tid = F.tid, lane = F.lane, wave = F.wave, fr = lane & 15, fq = lane >> 4;
    const int q4 = (lane & 15) >> 2, p4 = lane & 3;
    const bool outw = wave < 4; const int mt = wave & 3, ws4 = wave & 3;
    for (int unit0 = blockIdx.x; unit0 < 256; unit0 += F.G) {
        const int unit = (F.G == 256) ? (((unit0 & 7) * 2 + (unit0 >> 7)) * 16 + ((unit0 >> 3) & 15)) : unit0;
        const int bh = unit >> 4, jsl = unit & 15, b = bh >> 2, h = bh & 3;
        __syncthreads();
        for (int i = tid; i < 2 * 48 * CT_STRIDE / 2; i += 512) ((LAS unsigned*)CT)[i] = 0u;
        for (int i = tid; i < 2 * 64; i += 512) {
#pragma unroll
            for (int q = 0; q < 8; ++q) ((LAS unsigned*)(VT + i * VT_STRIDE + 32))[q] = (q == 0) ? 0x00003F80u : 0u;
        }
        f32x4 cst[4][3];
#pragma unroll
        for (int dt = 0; dt < 4; ++dt)
#pragma unroll
            for (int v3 = 0; v3 < 3; ++v3) cst[dt][v3] = (f32x4){0.f, 0.f, 0.f, 0.f};
        bf16x8 ab[8], nab[8]; u32x2 nv; float dec, ndec;
        const int vrow = tid >> 3, vpc = tid & 7;
#define P10_LOAD(cc) do { const size_t cb_ = (size_t)(bh * 64 + (cc)); \
            if (outw) { \
                _Pragma("unroll") for (int kk = 0; kk < 8; ++kk) nab[kk] = *(const bf16x8*)(QG + (((cb_ * 4 + mt) * 8 + kk) * 64 + lane) * 8); \
            } else { \
                _Pragma("unroll") for (int q = 0; q < 8; ++q) nab[q] = *(const bf16x8*)(KT + (((cb_ * 16 + 4 * ws4 + (q >> 1)) * 2 + (q & 1)) * 64 + lane) * 8); \
                ndec = DEC[bh * 64 + (cc)]; \
            } \
            nv = *(const u32x2*)(V + (size_t)(b * T + 64 * (cc) + vrow) * 2048 + h * 512 + 32 * jsl + 4 * vpc); } while (0)
#define P10_ROTATE() do { _Pragma("unroll") for (int q = 0; q < 8; ++q) ab[q] = nab[q]; dec = ndec; } while (0)
        ndec = 0.f;
        P10_LOAD(0);
        *(LAS u32x2*)(VT + vrow * VT_STRIDE + 4 * vpc) = nv;
        P10_ROTATE();
#pragma unroll 1
        for (int c = 0; c < 64; ++c) {
            const int cur = c & 1;
            LAS bf16* CTc = CT + cur * 48 * CT_STRIDE; LAS bf16* CTn = CT + (cur ^ 1) * 48 * CT_STRIDE;
            LAS bf16* VTc = VT + cur * 64 * VT_STRIDE; LAS bf16* VTn = VT + (cur ^ 1) * 64 * VT_STRIDE;
            LDS_WAIT(); __builtin_amdgcn_s_barrier(); asm volatile("" ::: "memory");
            { const int cn = (c + 1 < 64) ? c + 1 : 63; P10_LOAD(cn); }
            bf16x8 bv[3][2];
#pragma unroll
            for (int v3 = 0; v3 < 3; ++v3)
#pragma unroll
                for (int s2 = 0; s2 < 2; ++s2) {
                    const s16x4 lo = __builtin_amdgcn_ds_read_tr16_b64_v4i16((LAS s16x4*)(VTc + (32 * s2 + 4 * fq + q4) * VT_STRIDE + 16 * v3 + 4 * p4));
                    const s16x4 hi = __builtin_amdgcn_ds_read_tr16_b64_v4i16((LAS s16x4*)(VTc + (32 * s2 + 16 + 4 * fq + q4) * VT_STRIDE + 16 * v3 + 4 * p4));
                    bv[v3][s2] = (bf16x8){lo[0], lo[1], lo[2], lo[3], hi[0], hi[1], hi[2], hi[3]};
                }
            if (outw) {
                bf16x8 sf[2]; const size_t cb2 = (size_t)(bh * 64 + c);
#pragma unroll
                for (int s2 = 0; s2 < 2; ++s2) sf[s2] = *(const bf16x8*)(SS + (((cb2 * 4 + mt) * 2 + s2) * 64 + lane) * 8);
                const f32x4 e4 = *(const f32x4*)(EXPM + bh * 4096 + 64 * c + 16 * mt + 4 * fq);
                f32x4 o[3];
#pragma unroll
                for (int v3 = 0; v3 < 3; ++v3) o[v3] = (f32x4){0.f, 0.f, 0.f, 0.f};
#pragma unroll
                for (int kk = 0; kk < 8; ++kk) {
#pragma unroll
                    for (int v3 = 0; v3 < 3; ++v3) {
                        const bf16x8 bc = *(const LAS bf16x8*)(CTc + (16 * v3 + fr) * CT_STRIDE + 32 * kk + 8 * fq);
                        o[v3] = __builtin_amdgcn_mfma_f32_16x16x32_bf16(ab[kk], bc, o[v3], 0, 0, 0);
                    }
                    if (kk & 1) __builtin_amdgcn_sched_barrier(0);
                }
#pragma unroll
                for (int s2 = 0; s2 < 2; ++s2)
#pragma unroll
                    for (int v3 = 0; v3 < 3; ++v3) o[v3] = __builtin_amdgcn_mfma_f32_16x16x32_bf16(sf[s2], bv[v3][s2], o[v3], 0, 0, 0);
                const size_t tokb = (size_t)(b * T + 64 * c + 16 * mt + 4 * fq);
                float sq[4];
#pragma unroll
                for (int rg = 0; rg < 4; ++rg) {
                    const float den = __shfl(o[2][rg], lane & 48);
                    const float rden = 1.f / fmaxf(fabsf(den), e4[rg]);
                    const float h0 = o[0][rg] * rden, h1 = o[1][rg] * rden;
                    bf16* hp = HH + (tokb + rg) * 2048 + h * 512 + 32 * jsl + fr;
                    hp[0] = (bf16)f2bf(h0); hp[16] = (bf16)f2bf(h1);
                    float sv = h0 * h0 + h1 * h1; sv += __shfl_xor(sv, 1); sv += __shfl_xor(sv, 2); sv += __shfl_xor(sv, 4); sv += __shfl_xor(sv, 8); sq[rg] = sv;
                }
                if (fr == 0) {
#pragma unroll
                    for (int rg = 0; rg < 4; ++rg) SSQ[((tokb + rg) * 4 + h) * 16 + jsl] = sq[rg];
                }
            } else {
#pragma unroll
                for (int dt = 0; dt < 4; ++dt)
#pragma unroll
                    for (int v3 = 0; v3 < 3; ++v3) {
                        f32x4 a = cst[dt][v3] * dec;
                        a = __builtin_amdgcn_mfma_f32_16x16x32_bf16(ab[2 * dt], bv[v3][0], a, 0, 0, 0);
                        a = __builtin_amdgcn_mfma_f32_16x16x32_bf16(ab[2 * dt + 1], bv[v3][1], a, 0, 0, 0);
                        cst[dt][v3] = a;
                        u32x2 w; w.x = pk2(a[0], a[1]); w.y = pk2(a[2], a[3]);
                        *(LAS u32x2*)(CTn + (16 * v3 + fr) * CT_STRIDE + 16 * (4 * ws4 + dt) + 4 * fq) = w;
                    }
            }
            *(LAS u32x2*)(VTn + vrow * VT_STRIDE + 4 * vpc) = nv; P10_ROTATE();
        }
#undef P10_ROTATE
#undef P10_LOAD
    }
}

struct Args { const float* in[17]; float* out; unsigned char* ws; int ph_lo, ph_hi; };
constexpr int N_PHASES = 13;

__global__ void __launch_bounds__(512, 2) mk_fwd(Args args) {
    extern __shared__ __attribute__((aligned(16))) unsigned char lds[];
    Frame F;
    F.lds = (LAS unsigned char*)lds;
    F.tid = threadIdx.x; F.lane = F.tid & 63; F.wave = __builtin_amdgcn_readfirstlane(F.tid >> 6); F.G = gridDim.x;
    F.x = args.in[0]; F.a_w_in = args.in[1]; F.a_kv_g = args.in[2]; F.a_w_uk = args.in[3]; F.a_w_uv = args.in[4]; F.a_w_out = args.in[5]; F.a_ln_g = args.in[6]; F.a_ln_b = args.in[7];
    F.b_w_in = args.in[8]; F.b_i_bias = args.in[9]; F.b_f_bias = args.in[10]; F.b_conv_w = args.in[11]; F.b_conv_b = args.in[12]; F.b_hn_g = args.in[13]; F.b_w_out = args.in[14];
    F.b_ln_g = args.in[15]; F.b_ln_b = args.in[16]; F.out = args.out; F.ws = args.ws;
    volatile LAS unsigned* MISC = (volatile LAS unsigned*)(F.lds + MISC_OFF);
    if (F.tid < 64) MISC[F.tid] = 0u;
    __syncthreads();
    const int lo = args.ph_lo, hi = args.ph_hi;
    XcdBarrier bar; bar.bar = (unsigned*)(F.ws + WS_CTL) + CW_BAR; bar.x = 0; bar.st = nullptr;
    if (hi - lo > 1) bar = xcd_barrier_post((unsigned*)(F.ws + WS_CTL) + CW_BAR, MISC + 8);
#ifndef PHMASK
#define PHMASK 0xFFFF
#endif
#define IN(k) (((PHMASK >> (k)) & 1) && lo <= (k) && (k) < hi)
#ifndef REPMASK
#define REPMASK 0
#endif
#define REP(k) for (int rep_ = 0; rep_ < ((((REPMASK) >> (k)) & 1) ? 2 : 1); ++rep_)
#define SEAM(k) do { if (IN(k) && IN((k) + 1)) xcd_barrier(bar); } while (0)
    typedef pg8::bf16_t pb;
    unsigned char* ws = F.ws;
    const int c = (int)blockIdx.x;

    if (IN(0)) { REP(0) p0_prologue(F); } SEAM(0);
    if (IN(1)) {
        pg8::Gemm g{(const pb*)(ws + WS_XB), (const pb*)(ws + WS_WA), M, 3072, 1024, 1024, 1024, 0}; pg8::StaticOrder S; S.init(M, 3072, F.G, c);
        pg8::EpiB2T<true> E{(pb*)(ws + WS_PA1), (pb*)(ws + WS_ZA), (pb*)(ws + WS_KIDX), 2048, 1024, 8, 1.f};
        REP(1) pg8::gemm_phase(F.lds, g, S, E);
    } SEAM(1);
    if (IN(2)) {
#if !defined(X_NO_CKV)
        p2_ckv(F);
        __syncthreads();
#endif
#if !defined(X_NO_QLAT)
        pg8::Gemm g{(const pb*)(ws + WS_PA1), (const pb*)(ws + WS_WUK), M, 2048, 128, 2048, 128, 128}; pg8::StaticOrder S; S.init(M, 2048, F.G, c);
        pg8::EpiB2T<false> E{(pb*)(ws + WS_QLAT), (pb*)(ws + WS_QLAT), nullptr, 2048, 2048, 1 << 30, 0.08838834764831845f};
        REP(12) pg8::gemm_phase(F.lds, g, S, E);
        __syncthreads();
#endif
#if !defined(X_NO_TOPK)
        REP(13) p3_index_topk(F);
#endif
    } SEAM(2);
    if (IN(3)) { REP(3) p4_attention(F); } SEAM(3);
    if (IN(4)) {
        pg8::Gemm g{(const pb*)(ws + WS_PA1), (const pb*)(ws + WS_WUVB), M, 1024, 512, 2048, 512, 512}; pg8::StaticOrder S; S.init(M, 1024, F.G, c);
        pg8::EpiSilu E{(pb*)(ws + WS_XB), 1024, (const pb*)(ws + WS_ZA), 1024};
        REP(4) pg8::gemm_phase(F.lds, g, S, E);
    } SEAM(4);
    if (IN(5)) {
        pg8::Gemm g{(const pb*)(ws + WS_XB), (const pb*)(ws + WS_WAO), M, 1024, 1024, 1024, 1024, 0}; pg8::StaticOrder S; S.init(M, 1024, F.G, c);
        pg8::EpiRes E{F.x, F.out, 1024, ALPHA};
        REP(5) pg8::gemm_phase(F.lds, g, S, E);
    } SEAM(5);
    if (IN(6)) { p_ln_rows<true>(F, F.a_ln_g, F.a_ln_b); } SEAM(6);
    if (IN(7)) {
        pg8::Gemm g{(const pb*)(ws + WS_XB), (const pb*)(ws + WS_WBI), M, 4096, 1024, 1024, 1024, 0}; pg8::StaticOrder S; S.init(M, 4096, F.G, c);
        pg8::EpiB2T<false> E{(pb*)(ws + WS_PA1), (pb*)(ws + WS_V), nullptr, 2048, 2048, 8, 1.f};
        REP(7) pg8::gemm_phase(F.lds, g, S, E);
    } SEAM(7);
    if (IN(8)) { REP(8) p9_chunk_prep(F); } SEAM(8);
    if (IN(9)) { REP(9) p10_scan(F); } SEAM(9);
    if (IN(10)) {
        pg8::Gemm g{(const pb*)(ws + WS_XB), (const pb*)(ws + WS_WBI) + (size_t)4096 * 1024, M, 4096, 1024, 1024, 1024, 0}; pg8::StaticOrder S; S.init(M, 4096, F.G, c);
        pg8::EpiGate E{(pb*)(ws + WS_PA1), (const float*)(ws + WS_SSQ), F.b_hn_g};
        pg8::gemm_phase(F.lds, g, S, E);
    } SEAM(10);
    if (IN(11)) {
        pg8::Gemm g{(const pb*)(ws + WS_PA1), (const pb*)(ws + WS_WBO), M, 1024, 2048, 2048, 2048, 0}; pg8::StaticOrder S; S.init(M, 1024, F.G, c);
        pg8::EpiRes E{F.out, F.out, 1024, ALPHA};
        pg8::gemm_phase(F.lds, g, S, E);
    } SEAM(11);
    if (IN(12)) { p_ln_rows<false>(F, F.b_ln_g, F.b_ln_b); }
#undef IN
#undef SEAM
}


#ifndef MK_CHECK
#define MK_CHECK 0
#endif
#if MK_CHECK
constexpr size_t WS_CHK = 32768;
constexpr size_t WS_SAVE_HH = 256 * 1024;
constexpr size_t WS_SAVE_X1 = 512 * 1024;
struct CA { const float* in[17]; float* out; unsigned char* ws; int id; };
DI unsigned hsh(unsigned x) { x ^= x >> 16; x *= 0x7feb352du; x ^= x >> 15; x *= 0x846ca68bu; x ^= x >> 16; return x; }
DI void chk_acc(unsigned char* ws, int id, float fast, float ref) {
    float d = (fast - ref); d = d * d; float r = ref * ref;
    if (!(d == d) || !(fast - fast == 0.f)) d = 1e30f;
    d = wave_sum(d); r = wave_sum(r);
    if ((threadIdx.x & 63) == 0) { atomicAdd((float*)(ws + WS_CHK) + 2 * id, d); atomicAdd((float*)(ws + WS_CHK) + 2 * id + 1, r); }
}
DI int samp_tok(int i) { return (int)(hsh(0x1234567u + i) % (unsigned)M); }
__global__ void __launch_bounds__(256) chk1(CA a) {
    const int i = blockIdx.x * 256 + threadIdx.x; const int tok = samp_tok(i), cs = (int)(hsh(i * 3 + 1) % 2888u);
    const float* x = a.in[0] + (size_t)tok * D; const float* w = a.in[1] + cs; float r = 0.f;
    for (int k = 0; k < D; ++k) r += x[k] * w[(size_t)k * A_IN];
    const bf16* PA1 = (const bf16*)(a.ws + WS_PA1); const bf16* ZA = (const bf16*)(a.ws + WS_ZA);
    const float f = cs < 1864 ? bf2f(PA1[(size_t)tok * 2048 + cs]) : bf2f(ZA[(size_t)tok * 1024 + cs - 1864]);
    chk_acc(a.ws, 1, f, r);
}
__global__ void __launch_bounds__(256) chk2(CA a) {
    const int i = blockIdx.x * 256 + threadIdx.x; const int tok = samp_tok(i);
    const bf16* PA1 = (const bf16*)(a.ws + WS_PA1);
    { const int c = (int)(hsh(i * 5 + 2) % 256u); float ss = 0.f; for (int k = 0; k < 256; ++k) { const float v = bf2f(PA1[(size_t)tok * 2048 + 1024 + k]); ss += v * v; }
      const float r = bf2f(PA1[(size_t)tok * 2048 + 1024 + c]) / sqrtf(ss / 256.f + LN_EPS) * a.in[2][c];
      chk_acc(a.ws, 2, bf2f(((const bf16*)(a.ws + WS_CKV))[(size_t)tok * 256 + c]), r); }
    { const int h = (int)(hsh(i * 7 + 3) % 8u), c = (int)(hsh(i * 11 + 4) % 256u); float r = 0.f;
      for (int d = 0; d < 128; ++d) r += bf2f(PA1[(size_t)tok * 2048 + h * 128 + d]) * a.in[3][((size_t)h * 128 + d) * 256 + c];
      r *= 0.08838834764831845f;
      chk_acc(a.ws, 3, bf2f(((const bf16*)(a.ws + WS_QLAT))[(size_t)tok * 2048 + h * 256 + c]), r); }
}
__global__ void __launch_bounds__(256) chk4(CA a) {
    __shared__ float sc[4096]; __shared__ float qi[512]; __shared__ float wi[8];
    const int tok = (blockIdx.x < 8) ? (int)(blockIdx.x * 37 + (blockIdx.x & 3) * T) : samp_tok(1000 + blockIdx.x); const int b = tok / T, t = tok % T, tid = threadIdx.x;
    const bf16* PA1 = (const bf16*)(a.ws + WS_PA1);
    for (int k = tid; k < 512; k += 256) qi[k] = bf2f(PA1[(size_t)tok * 2048 + 1280 + k]);
    if (tid < 8) wi[tid] = bf2f(PA1[(size_t)tok * 2048 + 1856 + tid]);
    __syncthreads();
    for (int s = tid; s <= t; s += 256) { float tot = 0.f;
        for (int h = 0; h < 8; ++h) { float d = 0.f; for (int k = 0; k < 64; ++k) d += qi[h * 64 + k] * bf2f(PA1[(size_t)(b * T + s) * 2048 + 1792 + k]); tot += wi[h] * fmaxf(d, 0.f); }
        sc[s] = tot; }
    __syncthreads();
    const int idx = ((const short*)(a.ws + WS_SEL))[(size_t)tok * 256 + tid]; const int nvalid = (t + 1 < 256) ? t + 1 : 256;
    float bad = 0.f;
    if (idx < 0) { bad = 1.f; }
    else if (idx > t) bad = 1.f;
    else { int rank = 0; for (int s = 0; s <= t; ++s) rank += (sc[s] > sc[idx]) ? 1 : 0; if (rank >= 258) bad = 1.f; }
    __shared__ int nv; if (tid == 0) nv = 0; __syncthreads(); if (idx >= 0) atomicAdd(&nv, 1); __syncthreads();
    if (idx < 0 && nv == nvalid) bad = 0.f;
    if (idx >= 0) {
        for (int e = 0; e < tid; ++e) if (((const short*)(a.ws + WS_SEL))[(size_t)tok * 256 + e] == idx) bad = 1.f; }
    chk_acc(a.ws, 4, bad, 0.f); if (tid == 0) atomicAdd((float*)(a.ws + WS_CHK) + 2 * 4 + 1, 256.f);
}
__global__ void __launch_bounds__(256) chk5(CA a) {
    __shared__ float lg[8][256]; __shared__ float ql[2048]; __shared__ int kid[256]; __shared__ float inv[8];
    const int tok = (blockIdx.x < 8) ? (int)(blockIdx.x * 37 + (blockIdx.x & 3) * T) : samp_tok(2000 + blockIdx.x); const int b = tok / T, t = tok % T, tid = threadIdx.x;
    const bf16* CKV = (const bf16*)(a.ws + WS_CKV); const bf16* QLAT = (const bf16*)(a.ws + WS_QLAT);
    for (int k = tid; k < 2048; k += 256) ql[k] = bf2f(QLAT[(size_t)tok * 2048 + k]);
    kid[tid] = ((const short*)(a.ws + WS_SEL))[(size_t)tok * 256 + tid];
    __syncthreads();
    const int kd = kid[tid];
    for (int h = 0; h < 8; ++h) { float d = -INFINITY;
        if (kd >= 0) { d = 0.f; for (int c = 0; c < 256; ++c) d += ql[h * 256 + c] * bf2f(CKV[(size_t)(b * T + kd) * 256 + c]); d -= exp2f(-(float)(h + 1)) * (float)(t - kd); }
        lg[h][tid] = d; }
    __syncthreads();
    if (tid < 8) { float mx = -INFINITY; for (int k = 0; k < 256; ++k) mx = fmaxf(mx, lg[tid][k]); float sm = 0.f; for (int k = 0; k < 256; ++k) { const float p = expf(lg[tid][k] - mx); lg[tid][k] = p; sm += p; } inv[tid] = 1.f / sm; }
    __syncthreads();
    const bf16* OLAT = (const bf16*)(a.ws + WS_PA1);
    for (int h = 0; h < 8; ++h) { float o = 0.f; for (int k = 0; k < 256; ++k) if (kid[k] >= 0) o += lg[h][k] * bf2f(CKV[(size_t)(b * T + kid[k]) * 256 + tid]);
        chk_acc(a.ws, 5, bf2f(OLAT[(size_t)tok * 2048 + h * 256 + tid]), o * inv[h]); }
}
__global__ void __launch_bounds__(256) chk6(CA a) {
    const int i = blockIdx.x * 256 + threadIdx.x; const int tok = samp_tok(3000 + i), n = (int)(hsh(i * 13 + 5) % 1024u), h = n >> 7, dd = n & 127;
    const bf16* OLAT = (const bf16*)(a.ws + WS_PA1); float o = 0.f;
    for (int c = 0; c < 256; ++c) o += bf2f(OLAT[(size_t)tok * 2048 + h * 256 + c]) * a.in[4][((size_t)h * 256 + c) * 128 + dd];
    const float z = bf2f(((const bf16*)(a.ws + WS_ZA))[(size_t)tok * 1024 + n]);
    chk_acc(a.ws, 6, bf2f(((const bf16*)(a.ws + WS_XB))[(size_t)tok * 1024 + n]), o * (z / (1.f + expf(-z))));
}
__global__ void __launch_bounds__(256) chk7(CA a) {
    const int i = blockIdx.x * 256 + threadIdx.x; const int tok = samp_tok(4000 + i), n = (int)(hsh(i * 17 + 6) % 1024u);
    const bf16* GZ = (const bf16*)(a.ws + WS_XB); float r = 0.f;
    for (int k = 0; k < 1024; ++k) r += bf2f(GZ[(size_t)tok * 1024 + k]) * a.in[5][(size_t)k * 1024 + n];
    r += ALPHA * a.in[0][(size_t)tok * D + n];
    chk_acc(a.ws, 7, a.out[(size_t)tok * D + n], r);
}
__global__ void __launch_bounds__(256) chk8(CA a) {
    __shared__ float u[1024]; __shared__ float red[256]; __shared__ float x1s[1024];
    const int tok = samp_tok(5000 + blockIdx.x), tid = threadIdx.x;
    const bf16* GZ = (const bf16*)(a.ws + WS_XB);
    (void)GZ;
    for (int k = tid; k < 1024; k += 256) x1s[k] = a.out[(size_t)tok * D + k];
    __syncthreads();
    float s = 0.f; for (int k = tid; k < 1024; k += 256) s += x1s[k]; red[tid] = s; __syncthreads();
    for (int o = 128; o > 0; o >>= 1) { if (tid < o) red[tid] += red[tid + o]; __syncthreads(); }
    (void)u;
    for (int k = tid; k < 1024; k += 256) chk_acc(a.ws, 8, bf2f(((const bf16*)(a.ws + WS_XB))[(size_t)tok * 1024 + k]), x1s[k]);
    if (tid < 64) { const int j = tid & 7; float g = 0.f; for (int k = 0; k < 1024; ++k) g += x1s[k] * a.in[8][(size_t)k * B_IN + 4096 + j];
        chk_acc(a.ws, 9, ((const float*)(a.ws + WS_GATES))[(size_t)tok * 8 + j], g); }
}
__global__ void __launch_bounds__(256) chk10_save(CA a) { const int tok = samp_tok(6000 + blockIdx.x); for (int k = threadIdx.x; k < 1024; k += 256) ((float*)(a.ws + WS_SAVE_X1))[blockIdx.x * 1024 + k] = a.out[(size_t)tok * D + k]; }
__global__ void __launch_bounds__(256) chk10(CA a) {
    __shared__ float red[256]; const int tok = samp_tok(6000 + blockIdx.x), tid = threadIdx.x; const float* u = (const float*)(a.ws + WS_SAVE_X1) + blockIdx.x * 1024;
    const float* gam = a.id == 10 ? a.in[6] : a.in[15]; const float* bet = a.id == 10 ? a.in[7] : a.in[16];
    float s = 0.f; for (int k = tid; k < 1024; k += 256) s += u[k]; red[tid] = s; __syncthreads();
    for (int o = 128; o > 0; o >>= 1) { if (tid < o) red[tid] += red[tid + o]; __syncthreads(); } const float mean = red[0] / 1024.f; __syncthreads();
    s = 0.f; for (int k = tid; k < 1024; k += 256) s += (u[k] - mean) * (u[k] - mean); red[tid] = s; __syncthreads();
    for (int o = 128; o > 0; o >>= 1) { if (tid < o) red[tid] += red[tid + o]; __syncthreads(); } const float rstd = 1.f / sqrtf(red[0] / 1024.f + LN_EPS);
    for (int k = tid; k < 1024; k += 256) chk_acc(a.ws, a.id, a.out[(size_t)tok * D + k], (u[k] - mean) * rstd * gam[k] + bet[k]);
}
__global__ void __launch_bounds__(256) chk11(CA a) {
    const int i = blockIdx.x * 256 + threadIdx.x; const int tok = samp_tok(7000 + i), col = (int)(hsh(i * 19 + 7) % 4096u); float r = 0.f;
    for (int k = 0; k < 1024; ++k) r += a.out[(size_t)tok * D + k] * a.in[8][(size_t)k * B_IN + col];
    const float f = col < 2048 ? bf2f(((const bf16*)(a.ws + WS_PA1))[(size_t)tok * 2048 + col]) : bf2f(((const bf16*)(a.ws + WS_V))[(size_t)tok * 2048 + col - 2048]);
    chk_acc(a.ws, 11, f, r);
}
DI float conv_ref(const CA& a, int b, int t, int gcol) {
    const bf16* QK = (const bf16*)(a.ws + WS_PA1); float acc = a.in[12][gcol];
    for (int j = 0; j < 4; ++j) { const int tt = t - 3 + j; if (tt >= 0) acc += a.in[11][j * 2048 + gcol] * bf2f(QK[(size_t)(b * T + tt) * 2048 + gcol]); }
    return acc / (1.f + expf(-acc));
}
__global__ void __launch_bounds__(256) chk12(CA a) {
    __shared__ float Fc[64], Ac[64], Gc[64]; __shared__ float Gprev, Gend;
    const int bh = blockIdx.x & 15, c = (int)(hsh(900 + blockIdx.x) % 64u), b = bh >> 2, h = bh & 3, tid = threadIdx.x, tb = 64 * c;
    const float* GATES = (const float*)(a.ws + WS_GATES);
    if (tid == 0) { float Fv = 0.f, mx = -INFINITY, gp = 0.f;
        for (int s = 0; s < tb + 64; ++s) { const float xg = GATES[(size_t)(b * T + s) * 8 + 4 + h] + a.in[10][h]; Fv += fminf(xg, 0.f) - log1pf(expf(-fabsf(xg)));
            const float av = GATES[(size_t)(b * T + s) * 8 + h] + a.in[9][h] - Fv; mx = fmaxf(mx, av); const float G = fmaxf(0.f, mx);
            if (s == tb - 1) gp = G; if (s >= tb) { Fc[s - tb] = Fv; Ac[s - tb] = av; Gc[s - tb] = G; } }
        Gprev = (c == 0) ? 0.f : gp; Gend = Gc[63]; }
    __syncthreads();
    if (tid < 64) chk_acc(a.ws, 12, ((const float*)(a.ws + WS_EXPM))[bh * 4096 + tb + tid], expf(-(Fc[tid] + Gc[tid])));
    if (tid < 64) chk_acc(a.ws, 13, ((const float*)(a.ws + WS_DEC))[bh * 64 + c], expf(Gprev - Gend));
    { const int tl = (int)(hsh(tid * 3 + blockIdx.x * 977) % 64u), d = (int)(hsh(tid * 5 + blockIdx.x * 131 + 1) % 256u);
      const float q = conv_ref(a, b, tb + tl, h * 256 + d) * 0.0625f * expf(Gprev - Gc[tl]);
      chk_acc(a.ws, 14, bf2f(((const bf16*)(a.ws + WS_QG))[((((size_t)(bh * 64 + c) * 4 + (tl >> 4)) * 8 + (d >> 5)) * 64 + ((d & 31) >> 3) * 16 + (tl & 15)) * 8 + (d & 7)]), q);
      const float k = conv_ref(a, b, tb + tl, 1024 + h * 256 + d) * expf(Ac[tl] - Gend);
      { const int u = tl & 31; chk_acc(a.ws, 15, bf2f(((const bf16*)(a.ws + WS_KT))[((((size_t)(bh * 64 + c) * 16 + (d >> 4)) * 2 + (tl >> 5)) * 64 + ((u & 15) >> 2) * 16 + (d & 15)) * 8 + (u & 3) + 4 * (u >> 4)]), k); } }
    { const int tl = (int)(hsh(tid * 7 + blockIdx.x * 313 + 2) % 64u), sl = (int)(hsh(tid * 11 + blockIdx.x * 717 + 3) % 64u); float r = 0.f;
      if (sl <= tl) { for (int d = 0; d < 256; ++d) r += conv_ref(a, b, tb + tl, h * 256 + d) * 0.0625f * conv_ref(a, b, tb + sl, 1024 + h * 256 + d); r *= expf(Ac[sl] - Gc[tl]); }
      { const int u = sl & 31; chk_acc(a.ws, 16, bf2f(((const bf16*)(a.ws + WS_SS))[((((size_t)(bh * 64 + c) * 4 + (tl >> 4)) * 2 + (sl >> 5)) * 64 + ((u & 15) >> 2) * 16 + (tl & 15)) * 8 + (u & 3) + 4 * (u >> 4)]), r); } }
}
__global__ void __launch_bounds__(256) chk17_pre(CA a) {
    __shared__ float Aa[4096]; __shared__ float cw[4096]; __shared__ float qh[256]; __shared__ float red[256]; __shared__ float Gt, mt;
    const int tok = (blockIdx.x < 4) ? (int)(blockIdx.x * T + 5 + 70 * blockIdx.x) : samp_tok(8000 + blockIdx.x); const int h = blockIdx.x & 3, b = tok / T, t = tok % T, tid = threadIdx.x;
    const float* GATES = (const float*)(a.ws + WS_GATES);
    if (tid == 0) { float Fv = 0.f, mx = -INFINITY;
        for (int s = 0; s <= t; ++s) { const float xg = GATES[(size_t)(b * T + s) * 8 + 4 + h] + a.in[10][h]; Fv += fminf(xg, 0.f) - log1pf(expf(-fabsf(xg)));
            const float av = GATES[(size_t)(b * T + s) * 8 + h] + a.in[9][h] - Fv; Aa[s] = av; mx = fmaxf(mx, av); }
        Gt = fmaxf(0.f, mx); mt = Fv + Gt; }
    qh[tid] = conv_ref(a, b, t, h * 256 + tid) * 0.0625f;
    __syncthreads();
    float dsum = 0.f;
    for (int s = tid; s <= t; s += 256) { float d = 0.f; for (int k = 0; k < 256; ++k) d += qh[k] * conv_ref(a, b, s, 1024 + h * 256 + k); d *= expf(Aa[s] - Gt); cw[s] = d; dsum += d; }
    red[tid] = dsum; __syncthreads();
    for (int o = 128; o > 0; o >>= 1) { if (tid < o) red[tid] += red[tid + o]; __syncthreads(); }
    const float den = fmaxf(fabsf(red[0]), expf(-mt));
    const bf16* V = (const bf16*)(a.ws + WS_V);
    for (int v = tid; v < 512; v += 256) { float num = 0.f; for (int s = 0; s <= t; ++s) num += cw[s] * bf2f(V[(size_t)(b * T + s) * 2048 + h * 512 + v]);
        ((float*)(a.ws + WS_SAVE_HH))[blockIdx.x * 512 + v] = num / den; }
}
__global__ void __launch_bounds__(256) chk17(CA a) {
    const int tok = (blockIdx.x < 4) ? (int)(blockIdx.x * T + 5 + 70 * blockIdx.x) : samp_tok(8000 + blockIdx.x); const int h = blockIdx.x & 3, tid = threadIdx.x;
    const bf16* HH = (const bf16*)(a.ws + WS_PA1); float ss = 0.f;
    for (int v = tid; v < 512; v += 256) { chk_acc(a.ws, 17, bf2f(HH[(size_t)tok * 2048 + h * 512 + v]), ((const float*)(a.ws + WS_SAVE_HH))[blockIdx.x * 512 + v]); }
    if (tid < 64) { float f = 0.f; for (int q = 0; q < 16; ++q) f += ((const float*)(a.ws + WS_SSQ))[((size_t)tok * 4 + h) * 16 + q];
        for (int v = 0; v < 512; ++v) { const float x = bf2f(HH[(size_t)tok * 2048 + h * 512 + v]); ss += x * x; }
        chk_acc(a.ws, 18, f, ss); }
}
__global__ void __launch_bounds__(256) chk19_pre(CA a) { const int tok = samp_tok(9000 + blockIdx.x); for (int k = threadIdx.x; k < 2048; k += 256) ((float*)(a.ws + WS_SAVE_HH))[blockIdx.x * 2048 + k] = bf2f(((const bf16*)(a.ws + WS_PA1))[(size_t)tok * 2048 + k]); }
__global__ void __launch_bounds__(256) chk19(CA a) {
    const int tok = samp_tok(9000 + blockIdx.x), tid = threadIdx.x; const float* hh = (const float*)(a.ws + WS_SAVE_HH) + blockIdx.x * 2048;
    const int col = (int)(hsh(tid * 23 + blockIdx.x * 29 + 8) % 2048u), head = col >> 9;
    float ss = 0.f; for (int v = 0; v < 512; ++v) ss += hh[head * 512 + v] * hh[head * 512 + v];
    float o = 0.f, z = 0.f; for (int k = 0; k < 1024; ++k) { const float xv = a.out[(size_t)tok * D + k]; o += xv * a.in[8][(size_t)k * B_IN + 4104 + col]; z += xv * a.in[8][(size_t)k * B_IN + 6152 + col]; }
    const float r = hh[col] / sqrtf(ss / 512.f + LN_EPS) * a.in[13][col] * (1.f / (1.f + expf(-o))) * (z / (1.f + expf(-z)));
    chk_acc(a.ws, 19, bf2f(((const bf16*)(a.ws + WS_PA1))[(size_t)tok * 2048 + col]), r);
}
__global__ void __launch_bounds__(256) chk20_pre(CA a) { const int tok = samp_tok(9500 + blockIdx.x); for (int k = threadIdx.x; k < 1024; k += 256) ((float*)(a.ws + WS_SAVE_X1))[blockIdx.x * 1024 + k] = a.out[(size_t)tok * D + k]; }
__global__ void __launch_bounds__(256) chk20(CA a) {
    const int tok = samp_tok(9500 + blockIdx.x), tid = threadIdx.x;
    for (int n = tid; n < 1024; n += 256) { float r = ALPHA * ((const float*)(a.ws + WS_SAVE_X1))[blockIdx.x * 1024 + n];
        for (int k = 0; k < 2048; ++k) r += bf2f(((const bf16*)(a.ws + WS_PA1))[(size_t)tok * 2048 + k]) * a.in[14][(size_t)k * 1024 + n];
        chk_acc(a.ws, 20, a.out[(size_t)tok * D + n], r); }
}
__global__ void __launch_bounds__(256) chk_apply(CA a) {
    const float* ch = (const float*)(a.ws + WS_CHK); float scale = 0.f;
    if (MK_CHECK == 1) { for (int id = 1; id <= 21; ++id) { const float e = sqrtf(ch[2 * id] / fmaxf(ch[2 * id + 1], 1e-30f)); const float tol = (id == 4) ? 0.04f : 0.008f; if (ch[2 * id + 1] > 0.f && !(e < tol)) { scale = (float)id; break; } } }
    else { const int id = MK_CHECK - 100; scale = fminf(sqrtf(ch[2 * id] / fmaxf(ch[2 * id + 1], 1e-30f)), 1000.f); }
    for (size_t i = (size_t)blockIdx.x * 256 + threadIdx.x; i < (size_t)M * D; i += (size_t)gridDim.x * 256) a.out[i] *= (1.f + scale);
}
#endif

extern "C" void kernel_launch(void* const* d_in, const int* in_sizes, int n_in, void* d_out, int out_size, void* d_ws, size_t ws_size, hipStream_t stream) {
    static int grid = 0;
    if (grid == 0) {
        if (n_in != 17 || out_size != M * D || ws_size < WS_END) { fprintf(stderr, "kernel_launch: unexpected shapes (n_in %d out %d ws %zu)\n", n_in, out_size, ws_size); grid = -1; return; }
        int dev = 0, cus = 0, per_cu = 0;
        if (hipGetDevice(&dev) != hipSuccess || hipDeviceGetAttribute(&cus, hipDeviceAttributeMultiprocessorCount, dev) != hipSuccess) { grid = -1; return; }
        if (hipFuncSetAttribute((const void*)mk_fwd, hipFuncAttributeMaxDynamicSharedMemorySize, LDS_BYTES) != hipSuccess) { fprintf(stderr, "kernel_launch: hipFuncSetAttribute failed\n"); grid = -1; return; }
        if (hipOccupancyMaxActiveBlocksPerMultiprocessor(&per_cu, (const void*)mk_fwd, 512, LDS_BYTES) != hipSuccess || per_cu < 1) fprintf(stderr, "kernel_launch: occupancy query reports %d\n", per_cu);
        (void)hipGetLastError();
        grid = cus < 256 ? cus : 256;
    }
    if (grid < 0) return;
    (void)hipMemsetAsync((char*)d_ws + WS_CTL, 0, CTL_ZERO_BYTES, stream);
    Args a{};
    for (int i = 0; i < 17; ++i) a.in[i] = (const float*)d_in[i];
    a.out = (float*)d_out; a.ws = (unsigned char*)d_ws;
#if MK_ONE_LAUNCH
    a.ph_lo = 0; a.ph_hi = N_PHASES;
    hipLaunchKernelGGL(mk_fwd, dim3(grid), dim3(512), LDS_BYTES, stream, a);
#else
#if MK_CHECK
    CA ca{}; for (int i = 0; i < 17; ++i) ca.in[i] = (const float*)d_in[i]; ca.out = (float*)d_out; ca.ws = (unsigned char*)d_ws; ca.id = 0;
#endif
    for (int p = 0; p < 13; ++p) {
#if MK_CHECK
        if (p == 6) hipLaunchKernelGGL(chk10_save, dim3(32), dim3(256), 0, stream, ca);
        if (p == 9) hipLaunchKernelGGL(chk17_pre, dim3(32), dim3(256), 0, stream, ca);
        if (p == 10) hipLaunchKernelGGL(chk19_pre, dim3(32), dim3(256), 0, stream, ca);
        if (p == 11) hipLaunchKernelGGL(chk20_pre, dim3(32), dim3(256), 0, stream, ca);
#endif
        a.ph_lo = p; a.ph_hi = p + 1; hipLaunchKernelGGL(mk_fwd, dim3(grid), dim3(512), LDS_BYTES, stream, a);
#if MK_CHECK
        if (p == 1) hipLaunchKernelGGL(chk1, dim3(64), dim3(256), 0, stream, ca);
        if (p == 2) { hipLaunchKernelGGL(chk2, dim3(64), dim3(256), 0, stream, ca); hipLaunchKernelGGL(chk4, dim3(64), dim3(256), 0, stream, ca); }
        if (p == 3) hipLaunchKernelGGL(chk5, dim3(64), dim3(256), 0, stream, ca);
        if (p == 4) hipLaunchKernelGGL(chk6, dim3(64), dim3(256), 0, stream, ca);
        if (p == 5) hipLaunchKernelGGL(chk7, dim3(64), dim3(256), 0, stream, ca);
        if (p == 6) { ca.id = 10; hipLaunchKernelGGL(chk10, dim3(32), dim3(256), 0, stream, ca); hipLaunchKernelGGL(chk8, dim3(32), dim3(256), 0, stream, ca); }
        if (p == 7) hipLaunchKernelGGL(chk11, dim3(64), dim3(256), 0, stream, ca);
        if (p == 8) hipLaunchKernelGGL(chk12, dim3(64), dim3(256), 0, stream, ca);
        if (p == 9) hipLaunchKernelGGL(chk17, dim3(32), dim3(256), 0, stream, ca);
        if (p == 10) hipLaunchKernelGGL(chk19, dim3(32), dim3(256), 0, stream, ca);
        if (p == 11) hipLaunchKernelGGL(chk20, dim3(32), dim3(256), 0, stream, ca);
#endif
    }
#if MK_CHECK
    hipLaunchKernelGGL(chk_apply, dim3(1024), dim3(256), 0, stream, ca);
#endif
#endif
}
```
